# Optimizing an MI355X kernel written in HIP

```python
import math
import jax, jax.numpy as jnp
from jax import lax
import numpy as np


D_MODEL = 1024
BATCH = 1
SEQ = 16384
DEPTH = 2

GRID_W = 64
CTX_LEN = 256
SSM_WIDTH = D_MODEL // 2
SSM_GROUP = 16
SSM_GROUPS = SSM_WIDTH // SSM_GROUP
SSM_STATE = 64
CONV_WIDTH = D_MODEL
CONV_K = 31
FFN_HIDDEN = ((8 * D_MODEL // 3 + 255) // 256) * 256
N_MOD = 6
W_IN_COLS = SSM_WIDTH + 2 * CONV_WIDTH + 2 * D_MODEL
EPS = 1e-6
STEP_MIN = 1e-3
STEP_MAX = 1e-1
POS_BASE = 10000.0

kernel_name = 'hybrid_s5_conformer_dit_block'


def _rmsnorm(x, g):
    x32 = x.astype(jnp.float32)
    y = x32 * lax.rsqrt(jnp.mean(x32 * x32, axis=-1, keepdims=True) + EPS)
    return (y * g.astype(jnp.float32)).astype(x.dtype)


def _layernorm(x, g, b):
    x32 = x.astype(jnp.float32)
    mu = jnp.mean(x32, axis=-1, keepdims=True)
    xc = x32 - mu
    var = jnp.mean(xc * xc, axis=-1, keepdims=True)
    y = xc * lax.rsqrt(var + EPS) * g.astype(jnp.float32) + b.astype(jnp.float32)
    return y.astype(x.dtype)


def _modulate(x, g, shift, scale):
    return _rmsnorm(x, g) * (1 + scale) + shift


def _pos2d(rows, cols, dim, dtype):
    q = dim // 4
    omega = 1.0 / (POS_BASE ** (jnp.arange(q, dtype=jnp.float32) / q))
    r = jnp.repeat(jnp.arange(rows, dtype=jnp.float32), cols)[:, None] * omega
    cl = jnp.tile(jnp.arange(cols, dtype=jnp.float32), rows)[:, None] * omega
    return jnp.concatenate([jnp.sin(r), jnp.cos(r), jnp.sin(cl), jnp.cos(cl)], axis=-1).astype(dtype)


def _s5_discretize(lam_re, lam_im, log_step, b_re, b_im):
    lam_re = lam_re.astype(jnp.float32)
    lam_im = lam_im.astype(jnp.float32)
    b_re = b_re.astype(jnp.float32)
    b_im = b_im.astype(jnp.float32)
    dt = jnp.exp(log_step.astype(jnp.float32))[:, None]
    mag = jnp.exp(lam_re * dt)
    ang = lam_im * dt
    lb_re = mag * jnp.cos(ang)
    lb_im = mag * jnp.sin(ang)
    num_re = lb_re - 1.0
    num_im = lb_im
    den = lam_re * lam_re + lam_im * lam_im
    f_re = (num_re * lam_re + num_im * lam_im) / den
    f_im = (num_im * lam_re - num_re * lam_im) / den
    bt_re = f_re[..., None] * b_re - f_im[..., None] * b_im
    bt_im = f_re[..., None] * b_im + f_im[..., None] * b_re
    return lb_re, lb_im, bt_re, bt_im


def _scan_combine(e1, e2):
    a1r, a1i, b1r, b1i = e1
    a2r, a2i, b2r, b2i = e2
    return (a2r * a1r - a2i * a1i,
            a2r * a1i + a2i * a1r,
            a2r * b1r - a2i * b1i + b2r,
            a2r * b1i + a2i * b1r + b2i)


def _s5_states(u, lb_re, lb_im, bt_re, bt_im, h0, reverse):
    b, n, _ = u.shape
    ug = u.astype(jnp.float32).reshape(b, n, SSM_GROUPS, SSM_GROUP)
    bu_re = jnp.einsum('bngc,gpc->bngp', ug, bt_re)
    bu_im = jnp.einsum('bngc,gpc->bngp', ug, bt_im)
    if h0 is not None:
        h0_re, h0_im = h0
        edge = n - 1 if reverse else 0
        bu_re = bu_re.at[:, edge].add(lb_re * h0_re - lb_im * h0_im)
        bu_im = bu_im.at[:, edge].add(lb_re * h0_im + lb_im * h0_re)
    a_re = jnp.broadcast_to(lb_re, bu_re.shape)
    a_im = jnp.broadcast_to(lb_im, bu_im.shape)
    _, _, h_re, h_im = lax.associative_scan(_scan_combine, (a_re, a_im, bu_re, bu_im), reverse=reverse, axis=1)
    return h_re, h_im


def _s5_readout(h_re, h_im, c_re, c_im):
    b, n = h_re.shape[:2]
    y = jnp.einsum('bngp,gcp->bngc', h_re, c_re) - jnp.einsum('bngp,gcp->bngc', h_im, c_im)
    return y.reshape(b, n, SSM_WIDTH)


def _s5_bidirectional(u_lat, u_ctx, lam_re, lam_im, log_step, b_re, b_im, c_re, c_im, ctx_out):
    y_lat = []
    y_ctx = []
    for direction, reverse in ((0, False), (1, True)):
        lb_re, lb_im, bt_re, bt_im = _s5_discretize(lam_re[direction], lam_im[direction], log_step[direction], b_re[direction], b_im[direction])
        cr = c_re[direction].astype(jnp.float32)
        ci = c_im[direction].astype(jnp.float32)
        hc_re, hc_im = _s5_states(u_ctx, lb_re, lb_im, bt_re, bt_im, None, reverse)
        edge = 0 if reverse else -1
        h0 = (hc_re[:, edge], hc_im[:, edge])
        hl_re, hl_im = _s5_states(u_lat, lb_re, lb_im, bt_re, bt_im, h0, reverse)
        y_lat.append(_s5_readout(hl_re, hl_im, cr, ci))
        if ctx_out:
            y_ctx.append(_s5_readout(hc_re, hc_im, cr, ci))
    y_lat_sum = y_lat[0] + y_lat[1]
    y_ctx_sum = (y_ctx[0] + y_ctx[1]) if ctx_out else None
    return y_lat_sum, y_ctx_sum


def _mixer(p, y_ssm, ssm_d, w_glu, w_proj_a, dw_kernel, dw_bias, cn_g, cn_b, w_proj_b, w_out):
    o1 = SSM_WIDTH
    o2 = o1 + 2 * CONV_WIDTH
    o3 = o2 + D_MODEL
    u_a = p[..., :o1]
    v = p[..., o1:o2]
    g_a = p[..., o2:o3]
    g_b = p[..., o3:]
    ya = y_ssm.astype(u_a.dtype) + ssm_d * u_a
    ya = jax.nn.gelu(ya)
    ya = ya * jax.nn.sigmoid(ya @ w_glu)
    vb = v[..., :CONV_WIDTH] * jax.nn.sigmoid(v[..., CONV_WIDTH:])
    vb = lax.conv_general_dilated(vb, dw_kernel[:, None, :], window_strides=(1,),
                                  padding=((CONV_K // 2, CONV_K // 2),),
                                  dimension_numbers=('NWC', 'WIO', 'NWC'),
                                  feature_group_count=CONV_WIDTH) + dw_bias
    vb = jax.nn.silu(_layernorm(vb, cn_g, cn_b))
    merged = jax.nn.sigmoid(g_a) * (ya @ w_proj_a) + jax.nn.sigmoid(g_b) * (vb @ w_proj_b)
    return merged @ w_out


def _swiglu(h, wg, wu, wd):
    return (jax.nn.silu(h @ wg) * (h @ wu)) @ wd


def setup_inputs(seed: int = 0) -> dict:
    key = jax.random.key(seed)
    ks = jax.random.split(key, 32)
    f32 = jnp.float32

    def nrm(k, shape, scale):
        return jax.random.normal(k, shape, f32) * scale

    G, P, CH = SSM_GROUPS, SSM_STATE, SSM_GROUP
    lam_im_base = (jnp.pi * jnp.arange(P, dtype=f32))
    return {
        'x': nrm(ks[0], (BATCH, SEQ, D_MODEL), 1.0),
        'c': nrm(ks[1], (BATCH, D_MODEL), 1.0),
        'ctx': nrm(ks[2], (BATCH, CTX_LEN, D_MODEL), 1.0),
        'c_ctx': nrm(ks[3], (D_MODEL,), 1.0),
        'w_mod': nrm(ks[4], (DEPTH, D_MODEL, N_MOD * D_MODEL), 0.5 * D_MODEL ** -0.5),
        'b_mod': nrm(ks[5], (DEPTH, N_MOD * D_MODEL), 0.02),
        'norm1_g': 1.0 + nrm(ks[6], (DEPTH, D_MODEL), 0.05),
        'norm2_g': 1.0 + nrm(ks[7], (DEPTH, D_MODEL), 0.05),
        'w_in': nrm(ks[8], (DEPTH, D_MODEL, W_IN_COLS), D_MODEL ** -0.5),
        'ssm_lam_re': -0.5 + nrm(ks[9], (DEPTH, 2, G, P), 0.01),
        'ssm_lam_im': lam_im_base + nrm(ks[10], (DEPTH, 2, G, P), 0.01),
        'ssm_log_step': jax.random.uniform(ks[11], (DEPTH, 2, G), f32, math.log(STEP_MIN), math.log(STEP_MAX)),
        'ssm_b_re': nrm(ks[12], (DEPTH, 2, G, P, CH), (2 * CH) ** -0.5),
        'ssm_b_im': nrm(ks[13], (DEPTH, 2, G, P, CH), (2 * CH) ** -0.5),
        'ssm_c_re': nrm(ks[14], (DEPTH, 2, G, CH, P), (2 * P) ** -0.5),
        'ssm_c_im': nrm(ks[15], (DEPTH, 2, G, CH, P), (2 * P) ** -0.5),
        'ssm_d': nrm(ks[16], (DEPTH, SSM_WIDTH), 1.0),
        'w_glu': nrm(ks[17], (DEPTH, SSM_WIDTH, SSM_WIDTH), SSM_WIDTH ** -0.5),
        'w_proj_a': nrm(ks[18], (DEPTH, SSM_WIDTH, D_MODEL), SSM_WIDTH ** -0.5),
        'dw_kernel': nrm(ks[19], (DEPTH, CONV_K, CONV_WIDTH), CONV_K ** -0.5),
        'dw_bias': nrm(ks[20], (DEPTH, CONV_WIDTH), 0.02),
        'conv_norm_g': 1.0 + nrm(ks[21], (DEPTH, CONV_WIDTH), 0.05),
        'conv_norm_b': nrm(ks[22], (DEPTH, CONV_WIDTH), 0.02),
        'w_proj_b': nrm(ks[23], (DEPTH, CONV_WIDTH, D_MODEL), CONV_WIDTH ** -0.5),
        'w_out': nrm(ks[24], (DEPTH, D_MODEL, D_MODEL), D_MODEL ** -0.5),
        'w_ffn_gate': nrm(ks[25], (DEPTH, D_MODEL, FFN_HIDDEN), D_MODEL ** -0.5),
        'w_ffn_up': nrm(ks[26], (DEPTH, D_MODEL, FFN_HIDDEN), D_MODEL ** -0.5),
        'w_ffn_down': nrm(ks[27], (DEPTH, FFN_HIDDEN, D_MODEL), FFN_HIDDEN ** -0.5),
        'norm_f_g': 1.0 + nrm(ks[28], (D_MODEL,), 0.05),
    }


def reference(x, c, ctx, c_ctx, w_mod, b_mod, norm1_g, norm2_g, w_in,
              ssm_lam_re, ssm_lam_im, ssm_log_step, ssm_b_re, ssm_b_im, ssm_c_re, ssm_c_im, ssm_d,
              w_glu, w_proj_a, dw_kernel, dw_bias, conv_norm_g, conv_norm_b, w_proj_b, w_out,
              w_ffn_gate, w_ffn_up, w_ffn_down, norm_f_g):
    n_lat = x.shape[1]
    rows = n_lat // GRID_W
    x = x + _pos2d(rows, GRID_W, D_MODEL, x.dtype)[None]
    for l in range(DEPTH):
        last = l == DEPTH - 1
        mod = jax.nn.silu(c) @ w_mod[l] + b_mod[l]
        sh1, sc1, g1, sh2, sc2, g2 = jnp.split(mod[:, None, :], N_MOD, axis=-1)
        mod_c = jax.nn.silu(c_ctx) @ w_mod[l] + b_mod[l]
        csh1, csc1, cg1, csh2, csc2, cg2 = jnp.split(mod_c, N_MOD, axis=-1)

        h = _modulate(x, norm1_g[l], sh1, sc1)
        hc = _modulate(ctx, norm1_g[l], csh1, csc1)
        p = h @ w_in[l]
        pc = hc @ (w_in[l][:, :SSM_WIDTH] if last else w_in[l])
        y_lat, y_ctx = _s5_bidirectional(p[..., :SSM_WIDTH], pc[..., :SSM_WIDTH],
                                         ssm_lam_re[l], ssm_lam_im[l], ssm_log_step[l],
                                         ssm_b_re[l], ssm_b_im[l], ssm_c_re[l], ssm_c_im[l],
                                         not last)
        mix_params = (ssm_d[l], w_glu[l], w_proj_a[l], dw_kernel[l], dw_bias[l],
                      conv_norm_g[l], conv_norm_b[l], w_proj_b[l], w_out[l])
        x = x + g1 * _mixer(p, y_lat, *mix_params)
        x = x + g2 * _swiglu(_modulate(x, norm2_g[l], sh2, sc2), w_ffn_gate[l], w_ffn_up[l], w_ffn_down[l])
        if not last:
            ctx = ctx + cg1 * _mixer(pc, y_ctx, *mix_params)
            ctx = ctx + cg2 * _swiglu(_modulate(ctx, norm2_g[l], csh2, csc2), w_ffn_gate[l], w_ffn_up[l], w_ffn_down[l])
    return _rmsnorm(x, norm_f_g)
```

```cpp
#include <hip/hip_runtime.h>
#include <cstdio>
#include <cstdint>

namespace pg8 {
#define PG8_LAS __attribute__((address_space(3)))
typedef unsigned short bf16_t;
typedef short bf16x8 __attribute__((ext_vector_type(8)));
typedef float f32x4 __attribute__((ext_vector_type(4)));
typedef unsigned u32x4 __attribute__((ext_vector_type(4)));
constexpr int BM = 256, BK = 64, HALF = 128, HTB = HALF * BK * 2, STAGE_BYTES = 8 * HTB, NXCD = 8, WGM = 8;

__host__ __device__ __forceinline__ int lds_byte(int r, int c) { const int st = (r >> 4) * 2 + (c >> 5), rr = r & 15, cc = c & 31, ob = rr * 64 + cc * 2; return st * 1024 + (ob ^ (((ob >> 9) & 1) << 5)); }
__host__ __device__ __forceinline__ void stage_rc(int b, int& R, int& C) { const int st = b / 1024, sb = b % 1024, swz = sb ^ (((sb >> 9) & 1) << 5); R = (st >> 1) * 16 + swz / 64; C = (st & 1) * 32 + (swz % 64) / 2; }
__host__ __device__ __forceinline__ int perm32(int rho) { const int n = rho >> 4, i = rho & 15; return 8 * (i >> 2) + 4 * n + (i & 3); }

struct Unit { int pm, pn; };
struct Gemm { const bf16_t* A; const bf16_t* A2; const bf16_t* Bt; };
template <int K_, int LDA_, int JS_, int TSPLIT_, int TMID_, int APN_> struct Cfg { static constexpr int K = K_, lda = LDA_, jstride = JS_, tsplit = TSPLIT_, tmid = TMID_, apn = APN_; };

struct StaticOrder {
    int nM, nN, nwg, G, c;
    __host__ __device__ void init(int M, int N, int G_, int c_) { nM = M / BM; nN = N / BM; nwg = nM * nN; G = G_; c = c_; }
    __host__ __device__ bool next(int i, Unit& u) const {
        const long L = (long)i * G + c; if (L >= nwg) return false;
        int wgid = (int)L; { const int q = nwg / NXCD, r = nwg % NXCD, xcd = wgid % NXCD, off = wgid / NXCD; wgid = (xcd < r ? xcd * (q + 1) : r * (q + 1) + (xcd - r) * q) + off; }
        const int nig = WGM * nN, gid = wgid / nig, fm = gid * WGM, gsz = (nM - fm) < WGM ? (nM - fm) : WGM;
        u.pm = fm + ((wgid % nig) % gsz); u.pn = (wgid % nig) / gsz; return true;
    }
};

__device__ __forceinline__ unsigned cvt_pk_bf16(float lo, float hi) { unsigned r; asm volatile("v_cvt_pk_bf16_f32 %0, %1, %2" : "=v"(r) : "v"(lo), "v"(hi)); return r; }

template <class CF, class Epi, class Sched>
__device__ __forceinline__ void gemm_phase(PG8_LAS unsigned char* lds, const Gemm g, const Sched& S, const Epi& E, int wv) {
    int tid_; asm volatile("v_mbcnt_lo_u32_b32 %0, -1, 0\n\tv_mbcnt_hi_u32_b32 %0, -1, %0" : "=v"(tid_)); tid_ += wv * 64; asm volatile("" : "+v"(tid_));
    const int tid = tid_, wid = __builtin_amdgcn_readfirstlane(tid >> 6), lane = tid & 63, wr = wid >> 2, wc = wid & 3, fr = lane & 15, fq = lane >> 4;
    constexpr int K = CF::K, nt = K / BK, tsplit = CF::tsplit;
    unsigned voffA[2], voffB[2];
#pragma unroll
    for (int i = 0; i < 2; ++i) { int R, C; stage_rc(tid * 16 + i * 8192, R, C); const int Rb = Epi::PERM ? ((R & ~31) + perm32(R & 31)) : R;
        voffA[i] = (unsigned)(R * CF::lda + (C >> 4) * CF::jstride + (C & 15)) * 2u; voffB[i] = (unsigned)(Rb * K + C) * 2u; }
    constexpr size_t kstepA = (size_t)CF::jstride * 8, kstepB = (size_t)(BK * 2);
    constexpr size_t hstepA = (size_t)HALF * CF::lda * 2, hstepB = (size_t)HALF * K * 2;
    constexpr size_t tstepA = 2 * hstepA, tstepB = 2 * hstepB, apnb = (size_t)CF::apn * 2;
    const unsigned ldsw = (unsigned)wid * 1024u;
    const int aoff = lds_byte(wr * 64 + fr, fq * 8), boff = lds_byte(wc * 32 + fr, fq * 8);
#define PG8_SA(b, h) (((b) * 2 + (h)) * HTB)
#define PG8_SB(b, h) ((4 + (b) * 2 + (h)) * HTB)
#define PG8_STAGE(bufoff, gbase, voff) do { _Pragma("unroll") for (int _i = 0; _i < 2; ++_i) \
        __builtin_amdgcn_global_load_lds((const unsigned*)((const char*)(gbase) + (voff)[_i]), (PG8_LAS unsigned*)(lds + (bufoff) + ldsw + _i * 8192), 16, 0, 0); } while (0)
#define PG8_LDA(dst, b, h) do { _Pragma("unroll") for (int m = 0; m < 4; ++m) _Pragma("unroll") for (int k = 0; k < 2; ++k) dst[m][k] = *(const PG8_LAS bf16x8*)(lds + PG8_SA(b, h) + aoff + m * 2048 + k * 1024); } while (0)
#define PG8_LDB(dst, b, h) do { _Pragma("unroll") for (int n = 0; n < 2; ++n) _Pragma("unroll") for (int k = 0; k < 2; ++k) dst[n][k] = *(const PG8_LAS bf16x8*)(lds + PG8_SB(b, h) + boff + n * 2048 + k * 1024); } while (0)
#define PG8_MMA(ai, bj, At, Bt) do { __builtin_amdgcn_s_setprio(1); _Pragma("unroll") for (int m = 0; m < 4; ++m) _Pragma("unroll") for (int n = 0; n < 2; ++n) _Pragma("unroll") for (int k = 0; k < 2; ++k) \
        acc[ai][bj][m][n] = __builtin_amdgcn_mfma_f32_16x16x32_bf16(Bt[n][k], At[m][k], acc[ai][bj][m][n], 0, 0, 0); __builtin_amdgcn_s_setprio(0); } while (0)
#define PG8_WAIT_V(n) asm volatile("s_waitcnt vmcnt(" #n ")" ::: "memory")
#define PG8_WAIT_L(n) asm volatile("s_waitcnt lgkmcnt(" #n ")" ::: "memory")
#define PG8_BAR __builtin_amdgcn_s_barrier()
#define PG8_SCHED __builtin_amdgcn_sched_barrier(0)
#define PG8_UA(u)  ((const char*)g.A  + (size_t)(u).pm * tstepA + (size_t)(u).pn * apnb)
#define PG8_UA2(u) ((const char*)g.A2 + (size_t)(u).pm * tstepA + (size_t)(u).pn * apnb - (size_t)tsplit * kstepA)
    Unit cur, nxt; int ui = 0;
    if (!S.next(0, cur)) return;
    f32x4 acc[2][2][4][2];
#pragma unroll
    for (int a = 0; a < 2; ++a)
#pragma unroll
        for (int b = 0; b < 2; ++b)
#pragma unroll
            for (int m = 0; m < 4; ++m)
#pragma unroll
                for (int n = 0; n < 2; ++n) acc[a][b][m][n] = (f32x4){0.f, 0.f, 0.f, 0.f};
    bf16x8 At[4][2], B0[2][2], B1[2][2];
    const char* cA = PG8_UA(cur); const char* cA2 = PG8_UA2(cur); const char* cB = (const char*)g.Bt + (size_t)cur.pn * tstepB;
    PG8_STAGE(PG8_SB(0, 0), cB, voffB); PG8_STAGE(PG8_SB(0, 1), cB + hstepB, voffB); PG8_STAGE(PG8_SA(0, 0), cA, voffA); PG8_STAGE(PG8_SA(0, 1), cA + hstepA, voffA);
    if (wr == 1) PG8_BAR;
    PG8_WAIT_V(2); PG8_BAR;
    PG8_STAGE(PG8_SB(1, 0), cB + kstepB, voffB); PG8_STAGE(PG8_SA(1, 0), cA + kstepA, voffA); PG8_STAGE(PG8_SB(1, 1), cB + hstepB + kstepB, voffB);
    PG8_WAIT_V(6); PG8_BAR;
    for (;;) {
        const bool has_next = S.next(ui + 1, nxt);
        const char* nA = has_next ? PG8_UA(nxt) : cA; const char* nB = has_next ? (const char*)g.Bt + (size_t)nxt.pn * tstepB : cB;
        for (int t = 0; t < nt; t += 2) {
            if constexpr (Epi::MID) { if (t == CF::tmid) E.mid(acc, cur, wr, wc, fr, fq); }
            const bool last = (t == nt - 2);
            const char* a1 = ((t + 1 < tsplit) ? cA : cA2) + (size_t)(t + 1) * kstepA;
            const char* a2 = last ? nA : ((t + 2 < tsplit) ? cA : cA2) + (size_t)(t + 2) * kstepA;
            const char* b2 = last ? nB : cB + (size_t)(t + 2) * kstepB;
            const char* a3 = a2 + kstepA; const char* b3 = b2 + kstepB;
            PG8_LDB(B0, 0, 0); PG8_LDB(B1, 0, 1); PG8_SCHED; PG8_LDA(At, 0, 0); PG8_STAGE(PG8_SA(1, 1), a1 + hstepA, voffA);
            PG8_WAIT_V(8); PG8_WAIT_L(0); PG8_BAR; PG8_MMA(0, 0, At, B0); PG8_MMA(0, 1, At, B1); PG8_BAR; PG8_SCHED;
            PG8_LDA(At, 0, 1); PG8_STAGE(PG8_SB(0, 0), b2, voffB); PG8_STAGE(PG8_SB(0, 1), b2 + hstepB, voffB); PG8_STAGE(PG8_SA(0, 0), a2, voffA);
            PG8_WAIT_V(8); PG8_WAIT_L(0); PG8_BAR; PG8_MMA(1, 0, At, B0); PG8_MMA(1, 1, At, B1); PG8_BAR; PG8_SCHED;
            PG8_LDB(B0, 1, 0); PG8_LDB(B1, 1, 1); PG8_SCHED; PG8_LDA(At, 1, 0); PG8_STAGE(PG8_SA(0, 1), a2 + hstepA, voffA);
            PG8_WAIT_V(8); PG8_WAIT_L(0); PG8_BAR; PG8_MMA(0, 0, At, B0); PG8_MMA(0, 1, At, B1); PG8_BAR; PG8_SCHED;
            PG8_LDA(At, 1, 1); PG8_STAGE(PG8_SB(1, 0), b3, voffB); PG8_STAGE(PG8_SB(1, 1), b3 + hstepB, voffB); PG8_STAGE(PG8_SA(1, 0), a3, voffA);
            PG8_WAIT_V(8); PG8_WAIT_L(0); PG8_BAR; PG8_MMA(1, 0, At, B0); PG8_MMA(1, 1, At, B1); PG8_BAR; PG8_SCHED;
        }
        if (wr == 0) PG8_BAR;
        E(acc, cur, wr, wc, fr, fq);
        if (!has_next) break;
#pragma unroll
        for (int a = 0; a < 2; ++a)
#pragma unroll
            for (int b = 0; b < 2; ++b)
#pragma unroll
                for (int m = 0; m < 4; ++m)
#pragma unroll
                    for (int n = 0; n < 2; ++n) acc[a][b][m][n] = (f32x4){0.f, 0.f, 0.f, 0.f};
        cur = nxt; cA = nA; cA2 = PG8_UA2(cur); cB = nB; ++ui;
        if (wr == 1) PG8_BAR;
    }
    PG8_WAIT_V(0);
    PG8_BAR;
#undef PG8_SA
#undef PG8_SB
#undef PG8_STAGE
#undef PG8_LDA
#undef PG8_LDB
#undef PG8_MMA
#undef PG8_WAIT_V
#undef PG8_WAIT_L
#undef PG8_BAR
#undef PG8_SCHED
#undef PG8_UA
#undef PG8_UA2
}
}

constexpr int NWAVES = 8, NT = NWAVES * 64;
constexpr int D = 1024, SEQ = 16384, CTXN = 256, MR = SEQ + CTXN  ;
constexpr int SSMW = 512, NG = 32, NP = 64, FF = 2816, WIN = 4608, NMOD = 6 * D;
constexpr int NCH = MR / 16  , NCHP = 1280  ;
constexpr float EPS = 1e-6f;
constexpr size_t MiB = 1u << 20;
constexpr size_t WS_CTL = 0;
constexpr size_t WS_MOD = 64 * 1024;
constexpr size_t WS_A16 = 192 * 1024;
constexpr size_t WS_POSR = 256 * 1024, WS_POSC = 768 * 1024 + 0;
constexpr size_t WS_XC = 1 * MiB;
constexpr size_t WS_APOW = 2 * MiB;
constexpr size_t WS_BTC = 3 * MiB + 256 * 1024;
constexpr size_t WS_SS = 4 * MiB + 512 * 1024;
constexpr size_t WS_CV = 5 * MiB;
constexpr size_t WS_GV = 5 * MiB + 512 * 1024;
constexpr int NCV = WIN + 2 * FF;
constexpr size_t WS_WIN = 6 * MiB, WS_WGLU = 15 * MiB, WS_WPROJ = 15 * MiB + 512 * 1024, WS_WOUT = 18 * MiB + 512 * 1024;
constexpr size_t WS_BAM = 20 * MiB + 512 * 1024, WS_TC = 24 * MiB + 512 * 1024;
constexpr size_t WS_XR = 32 * MiB + 512 * 1024;
constexpr size_t WS_U = 65 * MiB, WS_HST = 81 * MiB + 256 * 1024;
constexpr size_t WS_WGU = 65 * MiB, WS_WD = 76 * MiB;
constexpr size_t WS_VB = 97 * MiB + 512 * 1024;
constexpr size_t WS_SA = 130 * MiB, WS_SB = 162 * MiB + 512 * 1024;
constexpr size_t WS_A2 = 195 * MiB;
constexpr size_t WS_HID = WS_VB;
constexpr size_t WS_BAM1 = 244 * MiB, WS_TC1 = 248 * MiB;
constexpr size_t WS_END = 256 * MiB;
static_assert(WS_HID + (size_t)MR * FF * 2 <= WS_A2, "hid overlay");
static_assert(WS_A2 + (size_t)MR * 1536 * 2 <= WS_END, "a2");
static_assert(WS_WD + (size_t)D * FF * 2 <= WS_VB, "wd");
static_assert(WS_BTC + 8192 * 32 * 4 <= WS_WIN && WS_APOW + 8192 * 34 * 4 <= WS_BTC, "small");

constexpr int LDS_BYTES = 147456, MISC_OFF = 131072 + 320;

#define LAS __attribute__((address_space(3)))
__device__ __forceinline__ int lane_id_v() { int l; asm volatile("v_mbcnt_lo_u32_b32 %0, -1, 0\n\tv_mbcnt_hi_u32_b32 %0, -1, %0" : "=v"(l)); return l; }
__device__ __forceinline__ int tid_of(int wv) { return wv * 64 + lane_id_v(); }
typedef unsigned short bf16;
typedef unsigned v4u __attribute__((ext_vector_type(4)));
typedef unsigned v2u __attribute__((ext_vector_type(2)));
typedef float f32x4 __attribute__((ext_vector_type(4)));
typedef float f32x2 __attribute__((ext_vector_type(2)));
using pg8::cvt_pk_bf16;

__device__ __forceinline__ float bf_lo(unsigned u) { return __uint_as_float(u << 16); }
__device__ __forceinline__ float bf_hi(unsigned u) { return __uint_as_float(u & 0xffff0000u); }
__device__ __forceinline__ unsigned f2bf(float f) { unsigned u = __float_as_uint(f); return (u + 0x7fffu + ((u >> 16) & 1u)) >> 16; }
__device__ __forceinline__ float sigm(float x) { return __builtin_amdgcn_rcpf(1.0f + __expf(-x)); }
__device__ __forceinline__ float silu_f(float x) { return x * sigm(x); }
__device__ __forceinline__ float gelu_tanh(float x) { return x * sigm(1.5957691216057308f * (x + 0.044715f * x * x * x)); }
__device__ __forceinline__ float wave_sum(float v) {
#pragma unroll
    for (int o = 1; o < 64; o <<= 1) v += __shfl_xor(v, o);
    return v;
}
__device__ __forceinline__ void sincos_cw(float x, float& s, float& c) {
    const float kf = rintf(x * 0.63661977236758134f);
    float r = fmaf(-kf, 1.5703125f, x); r = fmaf(-kf, 4.837512969970703125e-4f, r); r = fmaf(-kf, 7.54978995489188216e-8f, r);
    const float r2 = r * r;
    float sp = fmaf(r2, 2.7557319e-6f, -1.9841270e-4f); sp = fmaf(sp, r2, 8.3333333e-3f); sp = fmaf(sp, r2, -1.6666667e-1f); sp = fmaf(sp * r2, r, r);
    float cp = fmaf(r2, -2.7557319e-7f, 2.4801587e-5f); cp = fmaf(cp, r2, -1.3888889e-3f); cp = fmaf(cp, r2, 4.1666667e-2f); cp = fmaf(cp, r2, -0.5f); cp = fmaf(cp, r2, 1.0f);
    const int q = ((int)kf) & 3;
    const float ss = (q & 1) ? cp : sp, cc = (q & 1) ? sp : cp;
    s = (q & 2) ? -ss : ss; c = ((q + 1) & 2) ? -cc : cc;
}

struct Params {
    const float *x, *c, *ctx, *c_ctx, *w_mod, *b_mod, *norm1_g, *norm2_g, *w_in, *lam_re, *lam_im, *log_step, *b_re, *b_im, *c_re, *c_im, *ssm_d,
        *w_glu, *w_proj_a, *dw_kernel, *dw_bias, *cn_g, *cn_b, *w_proj_b, *w_out, *w_gate, *w_up, *w_down, *norm_f_g;
    float* out; unsigned char* ws;
};
__device__ __forceinline__ Params load_params() {
    Params p{};
#if defined(__HIP_DEVICE_COMPILE__)
    typedef const void* cvp;
    const __attribute__((address_space(4))) cvp* kp = (const __attribute__((address_space(4))) cvp*)__builtin_amdgcn_kernarg_segment_ptr(); asm volatile("" : "+s"(kp));
    cvp* dst = (cvp*)&p;
#pragma unroll
    for (int i = 0; i < 31; ++i) dst[i] = kp[i];
#endif
    return p;
}

#define XB_TMO      128
#define XB_XCNT(j)  (256  + 64 * (j))
#define XB_XSUB(j)  (1280 + 64 * (j))
#define XB_XGEN(j)  (2304 + 64 * (j))
#define XB_TOP      3328
#define XB_TOPGEN   3392
#define XCD_BAR_WORDS 3456
#define XB_SPIN_CAP (1u << 18)
__device__ __forceinline__ unsigned xb_ld(unsigned* p)              { return __hip_atomic_load(p, __ATOMIC_RELAXED, __HIP_MEMORY_SCOPE_AGENT); }
__device__ __forceinline__ unsigned xb_add(unsigned* p, unsigned v) { return __hip_atomic_fetch_add(p, v, __ATOMIC_RELAXED, __HIP_MEMORY_SCOPE_AGENT); }
__device__ __forceinline__ unsigned xb_xcc_id() { return (unsigned)__builtin_amdgcn_s_getreg((3 << 11) | 20) & 0xFu; }
#define XB_SPIN(cond, bar) do { unsigned _sp = 0; while (cond) { __builtin_amdgcn_s_sleep(1); \
    if ((++_sp & 255u) == 0u) { if (xb_ld(&(bar)[XB_TMO])) break; if (_sp > XB_SPIN_CAP) { atomicAdd(&(bar)[XB_TMO], 1u); break; } } } } while (0)
struct XcdBarrier { unsigned* bar; unsigned x; volatile LAS unsigned* st; int wv; };
__device__ __forceinline__ XcdBarrier xcd_barrier_post(unsigned* bar, volatile LAS unsigned* st, int wv) {
    XcdBarrier b; b.bar = bar; b.x = xb_xcc_id(); b.st = st; b.wv = wv;
    if (tid_of(wv) == 0) (void)xb_add(&bar[XB_XCNT(b.x)], 1u);
    return b;
}
__device__ __forceinline__ void xcd_barrier_complete(unsigned* bar, unsigned x, unsigned& nloc, unsigned& nx) {
    const unsigned G = gridDim.x * gridDim.y * gridDim.z;
    unsigned sum, cnt, mine, sp = 0u;
    for (;;) {
        sum = 0u; cnt = 0u; mine = 0u;
#pragma unroll
        for (unsigned j = 0; j < 16; ++j) { const unsigned c = xb_ld(&bar[XB_XCNT(j)]); sum += c; cnt += (c > 0u) ? 1u : 0u; mine = (j == x) ? c : mine; }
        if (sum == G) break;
        __builtin_amdgcn_s_sleep(1);
        if ((++sp & 255u) == 0u) { if (xb_ld(&bar[XB_TMO])) break; if (sp > XB_SPIN_CAP) { atomicAdd(&bar[XB_TMO], 1u); break; } }
    }
    nloc = mine > 0u ? mine : 1u; nx = cnt > 0u ? cnt : 1u;
}
__device__ __forceinline__ void xcd_barrier(const XcdBarrier& b0) {
    asm volatile("s_waitcnt vmcnt(0)" ::: "memory");
    __syncthreads();
    if (tid_of(b0.wv) == 0) {
        XcdBarrier b; b.bar = (unsigned*)(load_params().ws + WS_CTL); b.x = xb_xcc_id(); b.st = b0.st;
        unsigned* bar = b.bar;
        __builtin_amdgcn_s_waitcnt(0);
        unsigned nloc = b.st[0], nx = b.st[1];
        if (nloc == 0u) { xcd_barrier_complete(bar, b.x, nloc, nx); b.st[0] = nloc; b.st[1] = nx; }
        const unsigned old = xb_add(&bar[XB_XSUB(b.x)], 1u);
        const unsigned gen = old / nloc;
        if (old + 1u == (gen + 1u) * nloc) {
            __builtin_amdgcn_fence(__ATOMIC_RELEASE, "agent");
            asm volatile("s_waitcnt vmcnt(0)" ::: "memory");
            const unsigned og = xb_add(&bar[XB_TOP], 1u);
            const unsigned tg = og / nx;
            if (og + 1u == (tg + 1u) * nx) xb_add(&bar[XB_TOPGEN], 1u);
            else XB_SPIN(xb_ld(&bar[XB_TOPGEN]) == tg, bar);
            __builtin_amdgcn_fence(__ATOMIC_ACQUIRE, "agent");
            xb_add(&bar[XB_XGEN(b.x)], 1u);
            asm volatile("s_waitcnt vmcnt(0)" ::: "memory");
        } else {
            XB_SPIN(xb_ld(&bar[XB_XGEN(b.x)]) == gen, bar);
            __builtin_amdgcn_fence(__ATOMIC_ACQUIRE, "agent");
            asm volatile("s_waitcnt vmcnt(0)" ::: "memory");
        }
    }
    __syncthreads();
}

typedef pg8::f32x4 (AccT)[2][2][4][2];
#define FOR_AI_M _Pragma("unroll") for (int ai = 0; ai < 2; ++ai) _Pragma("unroll") for (int m = 0; m < 4; ++m)

struct EpiWin {
    static constexpr bool PERM = true, MID = false;
    bf16 *U, *VB, *SA, *SB; const float* SS; const float* CV;
    __device__ __forceinline__ void operator()(const AccT& acc, const pg8::Unit& u, int wr, int wc, int fr, int fq) const {
        const int row0 = u.pm * 256 + wr * 64 + fr, cl = wc * 32 + 8 * fq;
        const float* cv = CV + (u.pm >= 64 ? NCV : 0) + u.pn * 256 + cl;
        f32x4 c00 = *(const f32x4*)(cv), c01 = *(const f32x4*)(cv + 4), c10 = *(const f32x4*)(cv + 128), c11 = *(const f32x4*)(cv + 132);
        float rsv[2][4];
        FOR_AI_M rsv[ai][m] = SS[row0 + ai * 128 + m * 16];
        FOR_AI_M rsv[ai][m] = rsqrtf(rsv[ai][m] * (1.0f / D) + EPS);
        if (u.pn >= 2 && u.pn < 10) {
            FOR_AI_M { const int row = row0 + ai * 128 + m * 16; const float rs = rsv[ai][m];
                const f32x4 v0 = acc[ai][0][m][0] * rs + c00, v1 = acc[ai][0][m][1] * rs + c01, g0 = acc[ai][1][m][0] * rs + c10, g1 = acc[ai][1][m][1] * rs + c11;
                v4u w; w.x = cvt_pk_bf16(v0[0] * sigm(g0[0]), v0[1] * sigm(g0[1])); w.y = cvt_pk_bf16(v0[2] * sigm(g0[2]), v0[3] * sigm(g0[3]));
                w.z = cvt_pk_bf16(v1[0] * sigm(g1[0]), v1[1] * sigm(g1[1])); w.w = cvt_pk_bf16(v1[2] * sigm(g1[2]), v1[3] * sigm(g1[3]));
                *(v4u*)(VB + (size_t)row * 1024 + (u.pn - 2) * 128 + cl) = w; }
        } else {
            bf16* base; int ldc, colt; bool sg;
            if (u.pn < 2) { base = U; ldc = 512; colt = u.pn * 256; sg = false; }
            else if (u.pn < 14) { base = SA; ldc = 1024; colt = (u.pn - 10) * 256; sg = true; }
            else { base = SB; ldc = 1024; colt = (u.pn - 14) * 256; sg = true; }
            FOR_AI_M { const int row = row0 + ai * 128 + m * 16; const float rs = rsv[ai][m];
#pragma unroll
                for (int bj = 0; bj < 2; ++bj) { f32x4 v0 = acc[ai][bj][m][0] * rs + (bj ? c10 : c00), v1 = acc[ai][bj][m][1] * rs + (bj ? c11 : c01);
                    if (sg) { for (int i = 0; i < 4; ++i) { v0[i] = sigm(v0[i]); v1[i] = sigm(v1[i]); } }
                    v4u w; w.x = cvt_pk_bf16(v0[0], v0[1]); w.y = cvt_pk_bf16(v0[2], v0[3]); w.z = cvt_pk_bf16(v1[0], v1[1]); w.w = cvt_pk_bf16(v1[2], v1[3]);
                    *(v4u*)(base + (size_t)row * ldc + colt + bj * 128 + cl) = w; } }
        }
    }
};
struct EpiS1 {
    static constexpr bool PERM = false, MID = false;
    float* S;
    __device__ __forceinline__ void operator()(const AccT& acc, const pg8::Unit& u, int wr, int wc, int fr, int fq) const {
        float* sp = S + (size_t)(u.pm * 256 + wr * 64 + fr) * 8192 + u.pn * 256 + wc * 32 + 4 * fq;
        if (u.pm < 4) {
            FOR_AI_M {
#pragma unroll
                for (int bj = 0; bj < 2; ++bj)
#pragma unroll
                    for (int n = 0; n < 2; ++n) *(f32x4*)(sp + (size_t)(ai * 128 + m * 16) * 8192 + bj * 128 + n * 16) = acc[ai][bj][m][n]; asm volatile("" ::: "memory"); }
        } else if (wr == 0) {
#pragma unroll
            for (int bj = 0; bj < 2; ++bj)
#pragma unroll
                for (int n = 0; n < 2; ++n) *(f32x4*)(sp + bj * 128 + n * 16) = acc[0][bj][0][n];
        }
    }
};
struct EpiS3 {
    static constexpr bool PERM = true, MID = false;
    bf16* YA;
    __device__ __forceinline__ void operator()(const AccT& acc, const pg8::Unit& u, int wr, int wc, int fr, int fq) const {
        const int row0 = u.pm * 256 + wr * 64 + fr;
        FOR_AI_M { const int chunk = row0 + ai * 128 + m * 16;
#pragma unroll
            for (int bj = 0; bj < 2; ++bj) { const int col8 = bj * 128 + wc * 32 + 8 * fq, t = col8 >> 4, ch = u.pn * 16 + (col8 & 15);
                const f32x4 a0 = acc[ai][bj][m][0], a1 = acc[ai][bj][m][1];
                v4u w; w.x = cvt_pk_bf16(gelu_tanh(a0[0]), gelu_tanh(a0[1])); w.y = cvt_pk_bf16(gelu_tanh(a0[2]), gelu_tanh(a0[3]));
                w.z = cvt_pk_bf16(gelu_tanh(a1[0]), gelu_tanh(a1[1])); w.w = cvt_pk_bf16(gelu_tanh(a1[2]), gelu_tanh(a1[3]));
                *(v4u*)(YA + (size_t)(chunk * 16 + t) * 512 + ch) = w; } asm volatile("" ::: "memory"); }
    }
};
struct EpiGlu {
    static constexpr bool PERM = true, MID = false;
    const bf16* YA; bf16* A2;
    __device__ __forceinline__ void operator()(const AccT& acc, const pg8::Unit& u, int wr, int wc, int fr, int fq) const {
        const int row0 = u.pm * 256 + wr * 64 + fr, col0 = u.pn * 256 + wc * 32 + 8 * fq;
        v4u yv[2][4][2];
        FOR_AI_M { const int row = row0 + ai * 128 + m * 16;
#pragma unroll
            for (int bj = 0; bj < 2; ++bj) yv[ai][m][bj] = *(const v4u*)(YA + (size_t)row * 512 + col0 + bj * 128); }
        FOR_AI_M { const int row = row0 + ai * 128 + m * 16;
#pragma unroll
            for (int bj = 0; bj < 2; ++bj) { const int col = col0 + bj * 128; const v4u y = yv[ai][m][bj]; const f32x4 a0 = acc[ai][bj][m][0], a1 = acc[ai][bj][m][1];
                v4u w; w.x = cvt_pk_bf16(bf_lo(y.x) * sigm(a0[0]), bf_hi(y.x) * sigm(a0[1])); w.y = cvt_pk_bf16(bf_lo(y.y) * sigm(a0[2]), bf_hi(y.y) * sigm(a0[3]));
                w.z = cvt_pk_bf16(bf_lo(y.z) * sigm(a1[0]), bf_hi(y.z) * sigm(a1[1])); w.w = cvt_pk_bf16(bf_lo(y.w) * sigm(a1[2]), bf_hi(y.w) * sigm(a1[3]));
                *(v4u*)(A2 + (size_t)row * 1536 + col) = w; } }
    }
};
struct EpiMerged {
    static constexpr bool PERM = true, MID = true;
    const bf16 *SA, *SB; bf16* MG;
    __device__ __forceinline__ void mid(AccT& acc, const pg8::Unit& u, int wr, int wc, int fr_, int fq_) const {
        int fr = fr_, fq = fq_; asm volatile("" : "+v"(fr), "+v"(fq));
        const int row0 = u.pm * 256 + wr * 64 + fr, col0 = u.pn * 256 + wc * 32 + 8 * fq;
        FOR_AI_M { const int row = row0 + ai * 128 + m * 16;
#pragma unroll
            for (int bj = 0; bj < 2; ++bj) { const size_t off = (size_t)row * 1024 + col0 + bj * 128; const v4u a = *(const v4u*)(SA + off), b = *(const v4u*)(SB + off);
                f32x4& a0 = acc[ai][bj][m][0]; f32x4& a1 = acc[ai][bj][m][1];
                a0[0] *= bf_lo(a.x) * __builtin_amdgcn_rcpf(bf_lo(b.x)); a0[1] *= bf_hi(a.x) * __builtin_amdgcn_rcpf(bf_hi(b.x));
                a0[2] *= bf_lo(a.y) * __builtin_amdgcn_rcpf(bf_lo(b.y)); a0[3] *= bf_hi(a.y) * __builtin_amdgcn_rcpf(bf_hi(b.y));
                a1[0] *= bf_lo(a.z) * __builtin_amdgcn_rcpf(bf_lo(b.z)); a1[1] *= bf_hi(a.z) * __builtin_amdgcn_rcpf(bf_hi(b.z));
                a1[2] *= bf_lo(a.w) * __builtin_amdgcn_rcpf(bf_lo(b.w)); a1[3] *= bf_hi(a.w) * __builtin_amdgcn_rcpf(bf_hi(b.w)); } asm volatile("" ::: "memory"); }
    }
    __device__ __forceinline__ void operator()(const AccT& acc, const pg8::Unit& u, int wr, int wc, int fr, int fq) const {
        const int row0 = u.pm * 256 + wr * 64 + fr, col0 = u.pn * 256 + wc * 32 + 8 * fq;
        v4u bv[2][4][2];
        FOR_AI_M { const int row = row0 + ai * 128 + m * 16;
#pragma unroll
            for (int bj = 0; bj < 2; ++bj) bv[ai][m][bj] = *(const v4u*)(SB + (size_t)row * 1024 + col0 + bj * 128); }
        FOR_AI_M { const int row = row0 + ai * 128 + m * 16;
#pragma unroll
            for (int bj = 0; bj < 2; ++bj) { const size_t off = (size_t)row * 1024 + col0 + bj * 128; const v4u b = bv[ai][m][bj]; const f32x4 a0 = acc[ai][bj][m][0], a1 = acc[ai][bj][m][1];
                v4u w; w.x = cvt_pk_bf16(a0[0] * bf_lo(b.x), a0[1] * bf_hi(b.x)); w.y = cvt_pk_bf16(a0[2] * bf_lo(b.y), a0[3] * bf_hi(b.y));
                w.z = cvt_pk_bf16(a1[0] * bf_lo(b.z), a1[1] * bf_hi(b.z)); w.w = cvt_pk_bf16(a1[2] * bf_lo(b.w), a1[3] * bf_hi(b.w));
                *(v4u*)(MG + off) = w; } }
    }
};
template <bool XG, bool FIRST = false> struct EpiRes {
    static constexpr bool PERM = false, MID = false;
    float* X; const float* gate; const float* gv; bf16* XGo; float* SSo; const float* Xin; const float* posr; const float* posc;
    __device__ __forceinline__ void operator()(const AccT& acc, const pg8::Unit& u, int wr, int wc, int fr, int fq) const {
        const int row0 = u.pm * 256 + wr * 64 + fr, col0 = u.pn * 256 + wc * 32 + 4 * fq;
        const float* XL = FIRST ? Xin : X;
        const float* ptab = (u.pn < 2) ? posr + col0 : posc + (col0 - 512);
        f32x4 gg[2][2], gw[2][2];
#pragma unroll
        for (int bj = 0; bj < 2; ++bj)
#pragma unroll
            for (int n = 0; n < 2; ++n) { gg[bj][n] = *(const f32x4*)(gate + col0 + bj * 128 + n * 16); if (XG) gw[bj][n] = *(const f32x4*)(gv + col0 + bj * 128 + n * 16); }
        f32x4 cur[2][2], nxt[2][2];
        { const float* rp = XL + (size_t)row0 * D + col0; const float* pp = ptab + (size_t)((u.pn < 2) ? (row0 >> 6) : (row0 & 63)) * 512;
#pragma unroll
          for (int bj = 0; bj < 2; ++bj)
#pragma unroll
              for (int n = 0; n < 2; ++n) { cur[bj][n] = *(const f32x4*)(rp + bj * 128 + n * 16); if (FIRST) cur[bj][n] += *(const f32x4*)(pp + bj * 128 + n * 16); } }
#pragma unroll
        for (int it = 0; it < 8; ++it) { const int ai = it >> 2, m = it & 3; const int row = row0 + ai * 128 + m * 16; float* rp = X + (size_t)row * D + col0;
            if (it < 7) { const int r2 = row0 + ((it + 1) >> 2) * 128 + ((it + 1) & 3) * 16; const float* rn = XL + (size_t)r2 * D + col0; const float* pp = ptab + (size_t)((u.pn < 2) ? (r2 >> 6) : (r2 & 63)) * 512;
#pragma unroll
                for (int bj = 0; bj < 2; ++bj)
#pragma unroll
                    for (int n = 0; n < 2; ++n) { nxt[bj][n] = *(const f32x4*)(rn + bj * 128 + n * 16); if (FIRST) nxt[bj][n] += *(const f32x4*)(pp + bj * 128 + n * 16); } }
            asm volatile("" ::: "memory");
            float ss = 0.f;
#pragma unroll
            for (int bj = 0; bj < 2; ++bj)
#pragma unroll
                for (int n = 0; n < 2; ++n) { const f32x4 xv = cur[bj][n] + gg[bj][n] * acc[ai][bj][m][n]; *(f32x4*)(rp + bj * 128 + n * 16) = xv;
                    if (XG) { ss += (xv[0] * xv[0] + xv[1] * xv[1]) + (xv[2] * xv[2] + xv[3] * xv[3]); const f32x4 y = xv * gw[bj][n];
                        v2u w; w.x = cvt_pk_bf16(y[0], y[1]); w.y = cvt_pk_bf16(y[2], y[3]); *(v2u*)(XGo + (size_t)row * D + col0 + bj * 128 + n * 16) = w; } }
            if (XG) { ss += __shfl_xor(ss, 16); ss += __shfl_xor(ss, 32); if (fq == 0) atomicAdd(SSo + row, ss); }
            asm volatile("" ::: "memory");
#pragma unroll
            for (int bj = 0; bj < 2; ++bj)
#pragma unroll
                for (int n = 0; n < 2; ++n) cur[bj][n] = nxt[bj][n]; }
    }
};
struct EpiFinal {
    static constexpr bool PERM = false, MID = false;
    float* X; const float* gate; const float* gf; float* SSF; unsigned* cnt;
    __device__ __forceinline__ void operator()(AccT& acc, const pg8::Unit& u, int wr, int wc, int fr, int fq) const {
        const int row0 = u.pm * 256 + wr * 64 + fr, col0 = u.pn * 256 + wc * 32 + 4 * fq;
        f32x4 gg[2][2];
#pragma unroll
        for (int bj = 0; bj < 2; ++bj)
#pragma unroll
            for (int n = 0; n < 2; ++n) gg[bj][n] = *(const f32x4*)(gate + col0 + bj * 128 + n * 16);
        f32x4 cur[2][2], nxt[2][2];
        { const float* rp = X + (size_t)row0 * D + col0;
#pragma unroll
          for (int bj = 0; bj < 2; ++bj)
#pragma unroll
              for (int n = 0; n < 2; ++n) cur[bj][n] = *(const f32x4*)(rp + bj * 128 + n * 16); }
#pragma unroll
        for (int it = 0; it < 8; ++it) { const int ai = it >> 2, m = it & 3; const int row = row0 + ai * 128 + m * 16;
            if (it < 7) { const int r2 = row0 + ((it + 1) >> 2) * 128 + ((it + 1) & 3) * 16; const float* rn = X + (size_t)r2 * D + col0;
#pragma unroll
                for (int bj = 0; bj < 2; ++bj)
#pragma unroll
                    for (int n = 0; n < 2; ++n) nxt[bj][n] = *(const f32x4*)(rn + bj * 128 + n * 16); }
            float ss = 0.f;
#pragma unroll
            for (int bj = 0; bj < 2; ++bj)
#pragma unroll
                for (int n = 0; n < 2; ++n) { const f32x4 xv = cur[bj][n] + gg[bj][n] * acc[ai][bj][m][n]; acc[ai][bj][m][n] = xv; ss += (xv[0] * xv[0] + xv[1] * xv[1]) + (xv[2] * xv[2] + xv[3] * xv[3]); }
            ss += __shfl_xor(ss, 16); ss += __shfl_xor(ss, 32); if (fq == 0) __hip_atomic_fetch_add(SSF + row, ss, __ATOMIC_RELAXED, __HIP_MEMORY_SCOPE_AGENT);
#pragma unroll
            for (int bj = 0; bj < 2; ++bj)
#pragma unroll
                for (int n = 0; n < 2; ++n) cur[bj][n] = nxt[bj][n]; }
        asm volatile("s_waitcnt vmcnt(0)" ::: "memory");
        unsigned* c = cnt + 64 * u.pm;
        if (fr == 0 && fq == 0) __hip_atomic_fetch_add(c, 1u, __ATOMIC_RELEASE, __HIP_MEMORY_SCOPE_AGENT);
        for (unsigned sp = 0; sp < (1u << 22); ++sp) { if (__hip_atomic_load(c, __ATOMIC_RELAXED, __HIP_MEMORY_SCOPE_AGENT) >= 32u) break; __builtin_amdgcn_s_sleep(2); }
        __builtin_amdgcn_fence(__ATOMIC_ACQUIRE, "agent");
        f32x4 gn[2][2];
#pragma unroll
        for (int bj = 0; bj < 2; ++bj)
#pragma unroll
            for (int n = 0; n < 2; ++n) gn[bj][n] = *(const f32x4*)(gf + col0 + bj * 128 + n * 16);
        float rs[2][4];
        FOR_AI_M rs[ai][m] = __hip_atomic_load(SSF + row0 + ai * 128 + m * 16, __ATOMIC_RELAXED, __HIP_MEMORY_SCOPE_AGENT);
        FOR_AI_M { const float r = rsqrtf(rs[ai][m] * (1.0f / D) + EPS); float* rp = X + (size_t)(row0 + ai * 128 + m * 16) * D + col0;
#pragma unroll
            for (int bj = 0; bj < 2; ++bj)
#pragma unroll
                for (int n = 0; n < 2; ++n) *(f32x4*)(rp + bj * 128 + n * 16) = acc[ai][bj][m][n] * r * gn[bj][n]; }
    }
};
struct EpiFfn {
    static constexpr bool PERM = true, MID = false;
    bf16* H; const float* SS; const float* CV;
    __device__ __forceinline__ void operator()(const AccT& acc, const pg8::Unit& u, int wr, int wc, int fr, int fq) const {
        const int row0 = u.pm * 256 + wr * 64 + fr, col0 = u.pn * 128 + wc * 32 + 8 * fq;
        const float* cv = CV + (u.pm >= 64 ? NCV : 0) + u.pn * 256 + wc * 32 + 8 * fq;
        const f32x4 c00 = *(const f32x4*)(cv), c01 = *(const f32x4*)(cv + 4), c10 = *(const f32x4*)(cv + 128), c11 = *(const f32x4*)(cv + 132);
        float rsv[2][4];
        FOR_AI_M rsv[ai][m] = SS[row0 + ai * 128 + m * 16];
        FOR_AI_M rsv[ai][m] = rsqrtf(rsv[ai][m] * (1.0f / D) + EPS);
        FOR_AI_M { const int row = row0 + ai * 128 + m * 16; const float rs = rsv[ai][m];
            const f32x4 g0 = acc[ai][0][m][0] * rs + c00, g1 = acc[ai][0][m][1] * rs + c01, u0 = acc[ai][1][m][0] * rs + c10, u1 = acc[ai][1][m][1] * rs + c11;
            v4u w; w.x = cvt_pk_bf16(silu_f(g0[0]) * u0[0], silu_f(g0[1]) * u0[1]); w.y = cvt_pk_bf16(silu_f(g0[2]) * u0[2], silu_f(g0[3]) * u0[3]);
            w.z = cvt_pk_bf16(silu_f(g1[0]) * u1[0], silu_f(g1[1]) * u1[1]); w.w = cvt_pk_bf16(silu_f(g1[2]) * u1[2], silu_f(g1[3]) * u1[3]);
            *(v4u*)(H + (size_t)row * FF + col0) = w; }
    }
};

struct Ctx { int tid, lane, wave, G, bid, wv; unsigned char* lds; unsigned char* ws; };
__device__ __forceinline__ Ctx mkctx(unsigned char* lds, unsigned char* ws, int wv) { Ctx C; C.wv = wv; int t = tid_of(wv); asm volatile("" : "+v"(t)); C.tid = t; C.lane = t & 63; C.wave = __builtin_amdgcn_readfirstlane(t >> 6); C.G = gridDim.x; C.bid = blockIdx.x; asm volatile("" : "+s"(ws)); C.lds = lds; C.ws = ws; return C; }

__device__ __forceinline__ void transpose_item(const float* W, int N, bf16* WT, int ldk, int koff, int drow0, int k0, int n0, float* scr, int lane, const float* sh, float* cvo) {
    { float tv[32]; const float* wp = W + (size_t)(k0 + (lane >> 5)) * N + n0 + (lane & 31);
#pragma unroll
      for (int i = 0; i < 32; ++i) tv[i] = wp[(size_t)(2 * i) * N];
#pragma unroll
      for (int i = 0; i < 32; ++i) scr[(2 * i + (lane >> 5)) * 33 + (lane & 31)] = tv[i]; }
    asm volatile("s_waitcnt lgkmcnt(0)" ::: "memory");
    if (sh) {
        float a0 = 0.f, a1 = 0.f;
#pragma unroll 16
        for (int kk = 0; kk < 64; ++kk) { const float w = scr[kk * 33 + (lane & 31)]; a0 = fmaf(sh[k0 + kk], w, a0); a1 = fmaf(sh[NMOD + k0 + kk], w, a1); }
        if (lane < 32) { atomicAdd(cvo + drow0 + lane, a0); atomicAdd(cvo + NCV + drow0 + lane, a1); }
    }
    const int c = lane & 7;
#pragma unroll
    for (int j = 0; j < 4; ++j) { const int n = (lane >> 3) + 8 * j; const float* s = scr + (8 * c) * 33 + n;
        v4u o; o.x = cvt_pk_bf16(s[0 * 33], s[1 * 33]); o.y = cvt_pk_bf16(s[2 * 33], s[3 * 33]); o.z = cvt_pk_bf16(s[4 * 33], s[5 * 33]); o.w = cvt_pk_bf16(s[6 * 33], s[7 * 33]);
        *(v4u*)(WT + (size_t)(drow0 + n) * ldk + koff + k0 + 8 * c) = o; }
    asm volatile("s_waitcnt lgkmcnt(0)" ::: "memory");
}
__device__ __forceinline__ bool transpose_job(int& it, const float* W, int K, int N, bf16* WT, int ldk, int koff, int mode, float* scr, int lane, const float* sh = nullptr, float* cvo = nullptr) {
    const int nblk = N / 32, items = (K / 64) * nblk;
    if (it >= items) { it -= items; return false; }
    const int kb = it / nblk, nb = it % nblk, n0 = 32 * nb; int dr = n0;
    if (mode == 1) { if (n0 >= 512 && n0 < 1536) { const int c = n0 - 512; dr = 512 + (c >> 7) * 256 + (c & 127); } else if (n0 >= 1536 && n0 < 2560) { const int c = n0 - 1536; dr = 512 + (c >> 7) * 256 + 128 + (c & 127); } }
    else if (mode == 2) dr = (n0 >> 7) * 256 + (n0 & 127);
    else if (mode == 3) dr = (n0 >> 7) * 256 + 128 + (n0 & 127);
    transpose_item(W, N, WT, ldk, koff, dr, 64 * kb, n0, scr, lane, sh, cvo);
    return true;
}

__device__ __forceinline__ void rows_first(const Ctx& C0) {
    const Ctx C = mkctx(C0.lds, C0.ws, C0.wv); const Params P = load_params();
    const int gw = C.bid * NWAVES + C.wave, NGW = C.G * NWAVES, lane = C.lane;
    const float* modl = (const float*)(C.ws + WS_MOD);
    const float* posr = (const float*)(C.ws + WS_POSR); const float* posc = (const float*)(C.ws + WS_POSC);
    float* XC = (float*)(C.ws + WS_XC); float* SS = (float*)(C.ws + WS_SS); bf16* Hout = (bf16*)(C.ws + WS_XR);
    f32x4 gn[4];
#pragma unroll
    for (int j = 0; j < 4; ++j) gn[j] = *(const f32x4*)(P.norm1_g + 4 * lane + 256 * j);
    for (int row = gw; row < MR; row += NGW) {
        const bool isc = row >= SEQ; const float* mv = modl + (isc ? NMOD : 0);
        f32x4 v[4];
        if (isc) {
#pragma unroll
            for (int j = 0; j < 4; ++j) v[j] = *(const f32x4*)(P.ctx + (size_t)(row - SEQ) * D + 4 * lane + 256 * j);
        } else {
            const int pr = row >> 6, pc = row & 63;
#pragma unroll
            for (int j = 0; j < 4; ++j) { const int ch = 4 * lane + 256 * j; const f32x4 pe = (j < 2) ? *(const f32x4*)(posr + pr * 512 + ch) : *(const f32x4*)(posc + pc * 512 + ch - 512);
                v[j] = *(const f32x4*)(P.x + (size_t)row * D + ch) + pe; }
        }
        float* xo = isc ? XC + (size_t)(row - SEQ) * D : P.out + (size_t)row * D;
        float ss = 0.f;
#pragma unroll
        for (int j = 0; j < 4; ++j) { *(f32x4*)(xo + 4 * lane + 256 * j) = v[j]; ss += (v[j][0] * v[j][0] + v[j][1] * v[j][1]) + (v[j][2] * v[j][2] + v[j][3] * v[j][3]); }
        ss = wave_sum(ss); if (lane == 0) SS[row] = ss;
#pragma unroll
        for (int j = 0; j < 4; ++j) { const int ch = 4 * lane + 256 * j; const f32x4 sc = *(const f32x4*)(mv + D + ch);
            const f32x4 y = v[j] * gn[j] * (sc + 1.0f);
            v2u w; w.x = cvt_pk_bf16(y[0], y[1]); w.y = cvt_pk_bf16(y[2], y[3]);
            *(v2u*)(Hout + (size_t)row * D + ch) = w; }
    }
    for (int it = C.bid * NT + C.tid; it < 2 * 2 * 2 * D; it += C.G * NT) { const int k = it & (D - 1), nrm = (it >> 10) & 1, wh = (it >> 11) & 1, l = it >> 12;
        const float g = (nrm ? P.norm2_g : P.norm1_g)[l * D + k]; ((float*)(C.ws + WS_GV))[it] = g * (1.0f + modl[(size_t)(l * 2 + wh) * NMOD + (nrm ? 4 * D : D) + k]); }
}

__device__ __forceinline__ void phase_setup(const Ctx& C0) {
    const Ctx C = mkctx(C0.lds, C0.ws, C0.wv); const Params P = load_params(); (void)P;
    float* red = (float*)C.lds;
    for (int b = C.bid; b < 192; b += C.G) {
        const int l = b / 96, n0 = (b % 96) * 64, k0 = C.wave * 128;
        const float* W = P.w_mod + (size_t)l * D * NMOD + n0 + C.lane;
        float a0 = 0.f, a1 = 0.f;
#pragma unroll 32
        for (int k = 0; k < 128; ++k) { const float w = W[(size_t)(k0 + k) * NMOD]; a0 = fmaf(silu_f(P.c[k0 + k]), w, a0); a1 = fmaf(silu_f(P.c_ctx[k0 + k]), w, a1); }
        red[(C.wave * 2 + 0) * 64 + C.lane] = a0; red[(C.wave * 2 + 1) * 64 + C.lane] = a1;
        __syncthreads();
        if (C.wave < 2) { float s = 0.f;
#pragma unroll
            for (int w = 0; w < 8; ++w) s += red[(w * 2 + C.wave) * 64 + C.lane];
            ((float*)(C.ws + WS_MOD))[(size_t)(l * 2 + C.wave) * NMOD + n0 + C.lane] = s + P.b_mod[(size_t)l * NMOD + n0 + C.lane]; }
        __syncthreads();
    }
    const int gt = C.bid * NT + C.tid, NGT = C.G * NT;
    for (int it = gt; it < 5 * MR; it += NGT) ((float*)(C.ws + WS_SS))[it] = 0.f;
    for (int it = gt; it < 4 * NCV; it += NGT) ((float*)(C.ws + WS_CV))[it] = 0.f;
    for (int it = gt; it < 8192; it += NGT) {
        const float lr = P.lam_re[it], li = P.lam_im[it], dt = expf(P.log_step[it >> 6]);
        const float mag = expf(lr * dt); float sn, cs; sincos_cw(li * dt, sn, cs);
        const float ar = mag * cs, ai = mag * sn, nr = ar - 1.0f, ni = ai, den = lr * lr + li * li;
        const float fr_ = (nr * lr + ni * li) / den, fi_ = (ni * lr - nr * li) / den;
        float* ap = (float*)(C.ws + WS_APOW) + (size_t)it * 34; float pr = 1.f, pi = 0.f;
        for (int t = 0; t <= 16; ++t) { ap[2 * t] = pr; ap[2 * t + 1] = pi; const float qr = pr * ar - pi * ai, qi = pr * ai + pi * ar; if (t == 16) { ((float*)(C.ws + WS_A16))[2 * it] = pr; ((float*)(C.ws + WS_A16))[2 * it + 1] = pi; } pr = qr; pi = qi; }
        float* bt = (float*)(C.ws + WS_BTC) + (size_t)it * 32;
        for (int c = 0; c < 16; ++c) { const float br = P.b_re[(size_t)it * 16 + c], bi = P.b_im[(size_t)it * 16 + c]; bt[2 * c] = fr_ * br - fi_ * bi; bt[2 * c + 1] = fr_ * bi + fi_ * br; }
    }
    for (int it = gt; it < 320 * 256; it += NGT) {
        const int r = it >> 8, i = it & 255; const float om = 1.0f / powf(10000.0f, (float)i * (1.0f / 256.0f));
        const float pv = (float)(r < 256 ? r : r - 256); float sn, cs; sincos_cw(pv * om, sn, cs);
        float* T = (r < 256) ? (float*)(C.ws + WS_POSR) + (size_t)r * 512 : (float*)(C.ws + WS_POSC) + (size_t)(r - 256) * 512;
        T[i] = sn; T[256 + i] = cs;
    }
}

__device__ __forceinline__ void build_s5_mats(const Ctx& C0, int l, int sb, int sG) {
    const Ctx C = mkctx(C0.lds, C0.ws, C0.wv); const Params P = load_params(); (void)P;
    const int gt = sb * NT + C.tid, NGT = sG * NT;
    const float* apow = (const float*)(C.ws + WS_APOW) + (size_t)l * 4096 * 34;
    const float* btc = (const float*)(C.ws + WS_BTC) + (size_t)l * 4096 * 32;
    const float* cre = P.c_re + (size_t)l * 2 * NG * 16 * NP; const float* cim = P.c_im + (size_t)l * 2 * NG * 16 * NP;
    bf16* BAM = (bf16*)(C.ws + (l ? WS_BAM1 : WS_BAM)); bf16* TC = (bf16*)(C.ws + (l ? WS_TC1 : WS_TC));
    for (int it = gt; it < NG * 16 * 256; it += NGT) {
        const int cp = it & 15, c = (it >> 4) & 15, tau = (it >> 8) & 15, g = it >> 12;
        float kk[2];
#pragma unroll
        for (int d = 0; d < 2; ++d) { float s = 0.f; const float* cr = cre + ((size_t)(d * NG + g) * 16 + c) * NP; const float* ci = cim + ((size_t)(d * NG + g) * 16 + c) * NP;
            const float* ap = apow + (size_t)(d * NG + g) * NP * 34 + 2 * tau; const float* bt = btc + (size_t)(d * NG + g) * NP * 32 + 2 * cp;
#pragma unroll 16
            for (int p = 0; p < NP; ++p) { const float pr = ap[p * 34], pi = ap[p * 34 + 1], br = bt[p * 32], bi = bt[p * 32 + 1];
                const float zr = pr * br - pi * bi, zi = pr * bi + pi * br; s += cr[p] * zr - ci[p] * zi; }
            kk[d] = s; }
        bf16* T = TC + (size_t)g * 256 * 512;
        if (tau == 0) { const bf16 v = (bf16)f2bf(kk[0] + kk[1] + (c == cp ? P.ssm_d[(size_t)l * SSMW + g * 16 + c] : 0.f)); for (int t = 0; t < 16; ++t) T[(size_t)(t * 16 + c) * 512 + t * 16 + cp] = v; }
        else { const bf16 vf = (bf16)f2bf(kk[0]), vr = (bf16)f2bf(kk[1]);
            for (int t = tau; t < 16; ++t) { T[(size_t)(t * 16 + c) * 512 + (t - tau) * 16 + cp] = vf; T[(size_t)((t - tau) * 16 + c) * 512 + t * 16 + cp] = vr; } }
    }
    for (int it = gt; it < NG * 256 * 128; it += NGT) {
        const int p = it & 63, d = (it >> 6) & 1, c = (it >> 7) & 15, t = (it >> 11) & 15, g = it >> 15;
        const int e = d ? 16 - t : t + 1; const size_t ci_ = ((size_t)(d * NG + g) * 16 + c) * NP + p;
        const float cr = cre[ci_], ci = cim[ci_]; const float* ap = apow + ((size_t)(d * NG + g) * NP + p) * 34 + 2 * e;
        const float wr_ = cr * ap[0] - ci * ap[1], wi_ = cr * ap[1] + ci * ap[0];
        bf16* T = TC + ((size_t)g * 256 + t * 16 + c) * 512 + 256 + d * 128 + p;
        T[0] = (bf16)f2bf(wr_); T[64] = (bf16)f2bf(-wi_);
    }
    for (int it = gt; it < NG * 2 * NP * 256; it += NGT) {
        const int cp = it & 15, j = (it >> 4) & 15, p = (it >> 8) & 63, d = (it >> 14) & 1, g = it >> 15;
        const int e = d ? j : 15 - j; const float* ap = apow + ((size_t)(d * NG + g) * NP + p) * 34 + 2 * e; const float* bt = btc + ((size_t)(d * NG + g) * NP + p) * 32 + 2 * cp;
        const float vr = ap[0] * bt[0] - ap[1] * bt[1], vi = ap[0] * bt[1] + ap[1] * bt[0];
        bf16* B = BAM + ((size_t)g * 256 + d * 128 + p) * 256 + j * 16 + cp;
        B[0] = (bf16)f2bf(vr); B[(size_t)64 * 256] = (bf16)f2bf(vi);
    }
}

#define GAS __attribute__((address_space(1)))
template <int DIR, int N>
__device__ __forceinline__ void run_load(__amdgpu_buffer_rsrc_t RS, unsigned vs, float (&sr)[N], float (&si)[N]) {
    constexpr int STS = (DIR ? -8192 : 8192) * 4;
    const int bs = (int)(vs * 4u) + (DIR ? (N - 1) * STS : 0);
#pragma unroll
    for (int k = 0; k < N; ++k) { const int so = DIR ? (N - 1 - k) * (-STS) : k * STS; sr[k] = __builtin_bit_cast(float, __builtin_amdgcn_raw_buffer_load_b32(RS, bs, so, 0)); si[k] = __builtin_bit_cast(float, __builtin_amdgcn_raw_buffer_load_b32(RS, bs + 256, so, 0)); }
}
template <int DIR, int N, bool WRITE>
__device__ __forceinline__ void run_scan(__amdgpu_buffer_rsrc_t RH, unsigned vre, unsigned vim, const float (&sr)[N], const float (&si)[N], float ar, float ai, float& hr, float& hi) {
    constexpr int STH = (DIR ? -8192 : 8192) * 2;
    const int bre = (int)(vre * 2u) + (DIR ? (N - 1) * STH : 0), bim = (int)(vim * 2u) + (DIR ? (N - 1) * STH : 0);
#pragma unroll
    for (int k = 0; k < N; ++k) {
        if (WRITE) { const int so = DIR ? (N - 1 - k) * (-STH) : k * STH; __builtin_amdgcn_raw_buffer_store_b16((short)f2bf(hr), RH, bre, so, 0); __builtin_amdgcn_raw_buffer_store_b16((short)f2bf(hi), RH, bim, so, 0); }
        const float nr = ar * hr - ai * hi + sr[k], ni = ar * hi + ai * hr + si[k]; hr = nr; hi = ni; }
}
template <int DIR>
__device__ __forceinline__ void carry_scan_d(const Ctx& C, int l, int g) {
    constexpr int d = DIR; const int p = C.lane, w = C.wave;
    const __amdgpu_buffer_rsrc_t S = __builtin_amdgcn_make_buffer_rsrc((void*)(C.ws + WS_XR), 0, 0x7ffffffe, 0x00020000);
    const __amdgpu_buffer_rsrc_t H = __builtin_amdgcn_make_buffer_rsrc((void*)(C.ws + WS_HST), 0, 0x7ffffffe, 0x00020000);
    const float* a16p = (const float*)(C.ws + WS_A16) + 2 * ((size_t)((l * 2 + d) * NG + g) * NP + p);
    const float ar = a16p[0], ai = a16p[1];
    const int nre = d * 128 + p, nim = nre + 64;
    const unsigned ls = (unsigned)(g * 256 + d * 128 + p), lre = (unsigned)((nre >> 4) * 512 + g * 16 + (nre & 15)), lim = (unsigned)((nim >> 4) * 512 + g * 16 + (nim & 15));
    const int cc0 = DIR ? NCH - 1 : SEQ / 16;
    const int lc0 = DIR ? (SEQ / 16 - 1 - 128 * w) : 128 * w;
    constexpr int QS = DIR ? -32 : 32;
    const unsigned c0 = (unsigned)lc0 * 8192u, c1 = (unsigned)(lc0 + QS) * 8192u, c2 = (unsigned)(lc0 + 2 * QS) * 8192u, c3 = (unsigned)(lc0 + 3 * QS) * 8192u, cc = (unsigned)cc0 * 8192u;
    float* ends = (float*)C.lds;
    float er = 0.f, ei = 0.f, hr = 0.f, hi = 0.f;
    float q3r[32], q3i[32];
    {   float xr[16], xi[16], ar0[32], ai0[32], ar1[32], ai1[32];
        run_load<DIR, 16>(S, cc + ls, xr, xi); run_load<DIR, 32>(S, c0 + ls, ar0, ai0); run_load<DIR, 32>(S, c1 + ls, ar1, ai1);
        if (w == 0) run_scan<DIR, 16, true>(H, cc + lre, cc + lim, xr, xi, ar, ai, er, ei); else run_scan<DIR, 16, false>(H, 0u, 0u, xr, xi, ar, ai, er, ei);
        run_scan<DIR, 32, false>(H, 0u, 0u, ar0, ai0, ar, ai, hr, hi); run_scan<DIR, 32, false>(H, 0u, 0u, ar1, ai1, ar, ai, hr, hi); }
    {   float br[32], bi[32];
        run_load<DIR, 32>(S, c2 + ls, br, bi); run_load<DIR, 32>(S, c3 + ls, q3r, q3i);
        run_scan<DIR, 32, false>(H, 0u, 0u, br, bi, ar, ai, hr, hi); run_scan<DIR, 32, false>(H, 0u, 0u, q3r, q3i, ar, ai, hr, hi); }
    ends[(w * 64 + p) * 2] = hr; ends[(w * 64 + p) * 2 + 1] = hi;
    float pr = ar, pi = ai;
#pragma unroll
    for (int i = 0; i < 7; ++i) { const float qr = pr * pr - pi * pi, qi = 2.f * pr * pi; pr = qr; pi = qi; }
    float ar0[32], ai0[32], ar1[32], ai1[32];
    run_load<DIR, 32>(S, c0 + ls, ar0, ai0); run_load<DIR, 32>(S, c1 + ls, ar1, ai1);
    __syncthreads();
    hr = er; hi = ei;
    for (int ww = 0; ww < w; ++ww) { const float xr = ends[(ww * 64 + p) * 2], xi = ends[(ww * 64 + p) * 2 + 1]; const float nr = pr * hr - pi * hi + xr, ni = pr * hi + pi * hr + xi; hr = nr; hi = ni; }
    run_scan<DIR, 32, true>(H, c0 + lre, c0 + lim, ar0, ai0, ar, ai, hr, hi);
    { float br[32], bi[32]; run_load<DIR, 32>(S, c2 + ls, br, bi);
      run_scan<DIR, 32, true>(H, c1 + lre, c1 + lim, ar1, ai1, ar, ai, hr, hi);
      run_scan<DIR, 32, true>(H, c2 + lre, c2 + lim, br, bi, ar, ai, hr, hi); }
    run_scan<DIR, 32, true>(H, c3 + lre, c3 + lim, q3r, q3i, ar, ai, hr, hi);
    __syncthreads();
}
__device__ __forceinline__ void carry_scan(const Ctx& C0, int l, int gd) {
    const Ctx C = mkctx(C0.lds, C0.ws, C0.wv);
    if (gd & 1) carry_scan_d<1>(C, l, gd >> 1); else carry_scan_d<0>(C, l, gd >> 1);
}

template <int RR> struct ConvStep {
    static __device__ __forceinline__ void run(f32x2 (&acc)[32], const f32x2 (&wk)[31], const bf16* VB, int r0, int len) {
        ConvStep<RR - 1>::run(acc, wk, VB, r0, len);
        const int ir = r0 - 15 + RR, irc = ir < 0 ? 0 : (ir >= len ? len - 1 : ir);
        unsigned raw = *(const unsigned*)(VB + (size_t)irc * D); raw = (ir == irc) ? raw : 0u;
        const f32x2 v = (f32x2){bf_lo(raw), bf_hi(raw)};
        constexpr int J0 = RR - 30 > 0 ? RR - 30 : 0, J1 = RR < 31 ? RR : 31;
#pragma unroll
        for (int j = J0; j <= J1; ++j) acc[j] += v * wk[RR - j];
    }
};
template <> struct ConvStep<-1> { static __device__ __forceinline__ void run(f32x2 (&)[32], const f32x2 (&)[31], const bf16*, int, int) {} };
__device__ __forceinline__ void conv_tile(const Ctx& C0, int l, int tile) {
    const Ctx C = mkctx(C0.lds, C0.ws, C0.wv); const Params P = load_params();
    const int tid = C.tid; const bool isc = tile >= SEQ / 32; const int base = isc ? SEQ : 0, len = isc ? CTXN : SEQ, r0 = (isc ? tile - SEQ / 32 : tile) * 32;
    const bf16* VB = (const bf16*)(C.ws + WS_VB) + (size_t)base * D + 2 * tid;
    const float* dw = P.dw_kernel + (size_t)l * 31 * D + 2 * tid;
    f32x2 wk[31];
#pragma unroll
    for (int k = 0; k < 31; ++k) wk[k] = *(const f32x2*)(dw + (size_t)k * D);
    const f32x2 bias = *(const f32x2*)(P.dw_bias + (size_t)l * D + 2 * tid);
    f32x2 acc[32];
#pragma unroll
    for (int j = 0; j < 32; ++j) acc[j] = bias;
    ConvStep<61>::run(acc, wk, VB, r0, len);
    float* tl = (float*)C.lds;
#pragma unroll
    for (int j = 0; j < 32; ++j) *(f32x2*)(tl + j * D + 2 * tid) = acc[j];
    __syncthreads();
    bf16* A2 = (bf16*)(C.ws + WS_A2);
    const float* cg = P.cn_g + (size_t)l * D; const float* cb = P.cn_b + (size_t)l * D;
#pragma unroll
    for (int jj = 0; jj < 4; ++jj) { const int j = C.wave * 4 + jj; f32x4 v[4]; float s = 0.f;
#pragma unroll
        for (int q = 0; q < 4; ++q) { v[q] = *(const f32x4*)(tl + j * D + 4 * C.lane + 256 * q); s += (v[q][0] + v[q][1]) + (v[q][2] + v[q][3]); }
        const float mu = wave_sum(s) * (1.0f / D); float s2 = 0.f;
#pragma unroll
        for (int q = 0; q < 4; ++q) { v[q] = v[q] - mu; s2 += (v[q][0] * v[q][0] + v[q][1] * v[q][1]) + (v[q][2] * v[q][2] + v[q][3] * v[q][3]); }
        const float rstd = rsqrtf(wave_sum(s2) * (1.0f / D) + EPS);
#pragma unroll
        for (int q = 0; q < 4; ++q) { const int ch = 4 * C.lane + 256 * q; const f32x4 y = v[q] * rstd * *(const f32x4*)(cg + ch) + *(const f32x4*)(cb + ch);
            v2u w; w.x = cvt_pk_bf16(silu_f(y[0]), silu_f(y[1])); w.y = cvt_pk_bf16(silu_f(y[2]), silu_f(y[3]));
            *(v2u*)(A2 + (size_t)(base + r0 + j) * 1536 + 512 + ch) = w; } }
    __syncthreads();
}

__device__ __forceinline__ void rows_final(const Ctx& C0) {
    const Ctx C = mkctx(C0.lds, C0.ws, C0.wv); const Params P = load_params(); (void)P;
    const int gw = C.bid * NWAVES + C.wave, NGW = C.G * NWAVES, lane = C.lane;
    f32x4 gn[4];
#pragma unroll
    for (int j = 0; j < 4; ++j) gn[j] = *(const f32x4*)(P.norm_f_g + 4 * lane + 256 * j);
    for (int row = gw; row < SEQ; row += NGW) { float* xr = P.out + (size_t)row * D; f32x4 v[4]; float ss = 0.f;
#pragma unroll
        for (int j = 0; j < 4; ++j) { v[j] = *(const f32x4*)(xr + 4 * lane + 256 * j); ss += (v[j][0] * v[j][0] + v[j][1] * v[j][1]) + (v[j][2] * v[j][2] + v[j][3] * v[j][3]); }
        const float rstd = rsqrtf(wave_sum(ss) * (1.0f / D) + EPS);
#pragma unroll
        for (int j = 0; j < 4; ++j) *(f32x4*)(xr + 4 * lane + 256 * j) = v[j] * rstd * gn[j]; }
}


template <int K, int LDA, int MODE>
__device__ __forceinline__ void ctx_gemm(int wv, unsigned char* lds, const bf16* A, const bf16* Bt, const bf16* SA, const bf16* SB, bf16* MG, float* XC, const float* gate, const float* gv, bf16* XGo, float* SSo) {
    int t_ = tid_of(wv); asm volatile("" : "+v"(t_));
    const int lane = t_ & 63, wave = wv, r = lane & 15, q = lane >> 4, half = wave >> 2, w4 = wave & 3;
    constexpr int K0 = (MODE == 0) ? 512 : K / 2;
    pg8::f32x4* xch = (pg8::f32x4*)lds;
    for (int t0 = blockIdx.x * 4; t0 < 16 * 64; t0 += gridDim.x * 4) {
        const int task = t0 + w4, ni = task >> 4, mi = task & 15;
        const bf16* ap = A + (size_t)(mi * 16 + r) * LDA + 8 * q; const bf16* bp = Bt + (size_t)(ni * 16 + r) * K + 8 * q;
        pg8::f32x4 acc = {0.f, 0.f, 0.f, 0.f};
        constexpr int NS0 = K0 / 32, NS1 = (K - K0) / 32;
        if (!half) {
#pragma unroll 16
            for (int i = 0; i < NS0; ++i) { const pg8::bf16x8 a = *(const pg8::bf16x8*)(ap + 32 * i), b = *(const pg8::bf16x8*)(bp + 32 * i); acc = __builtin_amdgcn_mfma_f32_16x16x32_bf16(b, a, acc, 0, 0, 0); }
        } else {
#pragma unroll 16
            for (int i = 0; i < NS1; ++i) { const pg8::bf16x8 a = *(const pg8::bf16x8*)(ap + K0 + 32 * i), b = *(const pg8::bf16x8*)(bp + K0 + 32 * i); acc = __builtin_amdgcn_mfma_f32_16x16x32_bf16(b, a, acc, 0, 0, 0); }
        }
        if (half) xch[w4 * 64 + lane] = acc;
        __syncthreads();
        if (!half) {
            const pg8::f32x4 acc2 = xch[w4 * 64 + lane];
            const int row = mi * 16 + r, col = ni * 16 + 4 * q;
            if (MODE == 0) { const size_t off = (size_t)(SEQ + row) * D + col; const v2u a = *(const v2u*)(SA + off), b = *(const v2u*)(SB + off);
                v2u w; w.x = cvt_pk_bf16(bf_lo(a.x) * acc[0] + bf_lo(b.x) * acc2[0], bf_hi(a.x) * acc[1] + bf_hi(b.x) * acc2[1]);
                w.y = cvt_pk_bf16(bf_lo(a.y) * acc[2] + bf_lo(b.y) * acc2[2], bf_hi(a.y) * acc[3] + bf_hi(b.y) * acc2[3]);
                *(v2u*)(MG + off) = w; }
            else { f32x4* p = (f32x4*)(XC + (size_t)row * D + col); const f32x4 g = *(const f32x4*)(gate + col); f32x4 a4 = {acc[0] + acc2[0], acc[1] + acc2[1], acc[2] + acc2[2], acc[3] + acc2[3]}; const f32x4 xv = *p + g * a4; *p = xv;
                const f32x4 y = xv * *(const f32x4*)(gv + col); v2u w; w.x = cvt_pk_bf16(y[0], y[1]); w.y = cvt_pk_bf16(y[2], y[3]); *(v2u*)(XGo + (size_t)(SEQ + row) * D + col) = w;
                float ss = (xv[0] * xv[0] + xv[1] * xv[1]) + (xv[2] * xv[2] + xv[3] * xv[3]); ss += __shfl_xor(ss, 16); ss += __shfl_xor(ss, 32); if (q == 0) atomicAdd(SSo + SEQ + row, ss); }
        }
        __syncthreads();
    }
}

__device__ __forceinline__ void mixer_prep(unsigned char* lds, int wv, int l, int sb, int sG) {
    const Params P = load_params(); unsigned char* ws = P.ws; const Ctx C1 = mkctx(lds, ws, wv); float* scr = (float*)(lds + C1.wave * 16384);
    const float* sh = (const float*)(ws + WS_MOD) + (size_t)l * 2 * NMOD;
    float* cvo = (float*)(ws + WS_CV) + (size_t)l * 2 * NCV;
    for (int it0 = sb * NWAVES + C1.wave; ; it0 += sG * NWAVES) { int it = it0;
        if (transpose_job(it, P.w_in + (size_t)l * D * WIN, D, WIN, (bf16*)(ws + WS_WIN), D, 0, 1, scr, C1.lane, sh, cvo)) continue;
        if (transpose_job(it, P.w_glu + (size_t)l * SSMW * SSMW, SSMW, SSMW, (bf16*)(ws + WS_WGLU), SSMW, 0, 0, scr, C1.lane)) continue;
        if (transpose_job(it, P.w_proj_a + (size_t)l * SSMW * D, SSMW, D, (bf16*)(ws + WS_WPROJ), 1536, 0, 0, scr, C1.lane)) continue;
        if (transpose_job(it, P.w_proj_b + (size_t)l * D * D, D, D, (bf16*)(ws + WS_WPROJ), 1536, 512, 0, scr, C1.lane)) continue;
        if (transpose_job(it, P.w_out + (size_t)l * D * D, D, D, (bf16*)(ws + WS_WOUT), D, 0, 0, scr, C1.lane)) continue;
        break; }
}
__device__ __forceinline__ void ffn_prep(unsigned char* lds, int wv, int l, int sb, int sG) {
    const Params P = load_params(); unsigned char* ws = P.ws; const Ctx C1 = mkctx(lds, ws, wv); float* scr = (float*)(lds + C1.wave * 16384);
    const float* sh = (const float*)(ws + WS_MOD) + (size_t)l * 2 * NMOD + 3 * D;
    float* cvo = (float*)(ws + WS_CV) + (size_t)l * 2 * NCV + WIN;
    for (int it0 = sb * NWAVES + C1.wave; ; it0 += sG * NWAVES) { int it = it0;
        if (transpose_job(it, P.w_gate + (size_t)l * D * FF, D, FF, (bf16*)(ws + WS_WGU), D, 0, 2, scr, C1.lane, sh, cvo)) continue;
        if (transpose_job(it, P.w_up + (size_t)l * D * FF, D, FF, (bf16*)(ws + WS_WGU), D, 0, 3, scr, C1.lane, sh, cvo)) continue;
        if (transpose_job(it, P.w_down + (size_t)l * FF * D, FF, D, (bf16*)(ws + WS_WD), FF, 0, 0, scr, C1.lane)) continue;
        break; }
}

__device__ __forceinline__ void conv_grab(const Ctx& C0, int l, int maxn) {
    unsigned* cnt = (unsigned*)(C0.ws + WS_CTL) + 8192 + 64 * l;
    volatile LAS unsigned* slot = (volatile LAS unsigned*)((LAS unsigned char*)C0.lds + MISC_OFF) + 16;
    for (int n = 0; n < maxn; ++n) {
        if (tid_of(C0.wv) == 0) slot[0] = atomicAdd(cnt, 1u);
        __syncthreads();
        const int tile = (int)slot[0];
        __syncthreads();
        if (tile >= MR / 32) break;
        conv_tile(C0, l, tile);
    }
}

#define GRID_BAR() xcd_barrier(bar)
template <int L>
__device__ __forceinline__ void layer_body(const Ctx& C, unsigned char* lds, PG8_LAS unsigned char* ldsl, int wv, const XcdBarrier& bar) {
        constexpr int l = L; constexpr bool last = (L == 1);
        constexpr int mr = last ? SEQ : MR;
        { unsigned char* ws = load_params().ws; typedef pg8::Cfg<D, D, 16, 1 << 30, -1, 0> CF; pg8::Gemm g{(const bf16*)(ws + WS_XR), (const bf16*)(ws + WS_XR), (const bf16*)(ws + WS_WIN)};
          pg8::StaticOrder S; S.init(MR, WIN, C.G, C.bid);
          EpiWin E{(bf16*)(ws + WS_U), (bf16*)(ws + WS_VB), (bf16*)(ws + WS_SA), (bf16*)(ws + WS_SB), (const float*)(ws + WS_SS) + (size_t)(l * 2) * MR, (const float*)(ws + WS_CV) + (size_t)l * 2 * NCV};
          pg8::gemm_phase<CF>(ldsl, g, S, E, wv); }
        GRID_BAR();
        { unsigned char* ws = load_params().ws; typedef pg8::Cfg<256, 16 * SSMW, SSMW, 1 << 30, -1, 16> CF; pg8::Gemm g{(const bf16*)(ws + WS_U), (const bf16*)(ws + WS_U), (const bf16*)(ws + (l ? WS_BAM1 : WS_BAM))};
          pg8::StaticOrder S; S.init(NCHP, NG * 256, C.G, C.bid);
          EpiS1 E{(float*)(ws + WS_XR)};
          pg8::gemm_phase<CF>(ldsl, g, S, E, wv);
          if (C.bid >= (NCHP / 256) * NG) conv_grab(C, l, 1); }
        GRID_BAR();
        { if (C.G > 64) { if (C.bid < 64) carry_scan(C, l, C.bid); else conv_grab(C, l, 2); }
          else { for (int gd = C.bid; gd < 64; gd += C.G) carry_scan(C, l, gd); conv_grab(C, l, 2); } }
        GRID_BAR();
        { unsigned char* ws = load_params().ws; typedef pg8::Cfg<512, 16 * SSMW, SSMW, 4, -1, 16> CF; pg8::Gemm g{(const bf16*)(ws + WS_U), (const bf16*)(ws + WS_HST), (const bf16*)(ws + (l ? WS_TC1 : WS_TC))};
          pg8::StaticOrder S; S.init(NCHP, NG * 256, C.G, C.bid);
          EpiS3 E{(bf16*)(ws + WS_XR)};
          pg8::gemm_phase<CF>(ldsl, g, S, E, wv);
          if (C.bid >= (NCHP / 256) * NG) conv_grab(C, l, 1 << 20); else if (C.G <= (NCHP / 256) * NG) conv_grab(C, l, 1 << 20); }
        GRID_BAR();
        { unsigned char* ws = load_params().ws; typedef pg8::Cfg<SSMW, SSMW, 16, 1 << 30, -1, 0> CF; pg8::Gemm g{(const bf16*)(ws + WS_XR), (const bf16*)(ws + WS_XR), (const bf16*)(ws + WS_WGLU)};
          pg8::StaticOrder S; S.init(mr, SSMW, C.G, C.bid);
          EpiGlu E{(const bf16*)(ws + WS_XR), (bf16*)(ws + WS_A2)};
          pg8::gemm_phase<CF>(ldsl, g, S, E, wv);
          const int nu = (mr / 256) * 2;
          if (C.G > nu) { if (C.bid >= nu) ffn_prep(lds, wv, l, C.bid - nu, C.G - nu); } else ffn_prep(lds, wv, l, C.bid, C.G); }
        GRID_BAR();
        { unsigned char* ws = load_params().ws; typedef pg8::Cfg<1536, 1536, 16, 1 << 30, 8, 0> CF; pg8::Gemm g{(const bf16*)(ws + WS_A2), (const bf16*)(ws + WS_A2), (const bf16*)(ws + WS_WPROJ)};
          pg8::StaticOrder S; S.init(SEQ, D, C.G, C.bid);
          EpiMerged E{(const bf16*)(ws + WS_SA), (const bf16*)(ws + WS_SB), (bf16*)(ws + WS_VB)};
          pg8::gemm_phase<CF>(ldsl, g, S, E, wv);
          if constexpr (!last) ctx_gemm<1536, 1536, 0>(wv, lds, (const bf16*)(ws + WS_A2) + (size_t)SEQ * 1536, (const bf16*)(ws + WS_WPROJ), (const bf16*)(ws + WS_SA), (const bf16*)(ws + WS_SB), (bf16*)(ws + WS_VB), nullptr, nullptr, nullptr, nullptr, nullptr); }
        GRID_BAR();
        { unsigned char* ws = load_params().ws; typedef pg8::Cfg<D, D, 16, 1 << 30, -1, 0> CF; pg8::Gemm g{(const bf16*)(ws + WS_VB), (const bf16*)(ws + WS_VB), (const bf16*)(ws + WS_WOUT)};
          pg8::StaticOrder S; S.init(SEQ, D, C.G, C.bid);
          const float* modl = (const float*)(ws + WS_MOD) + (size_t)l * 2 * NMOD; const float* gvl = (const float*)(ws + WS_GV) + (size_t)(l * 4 + 1) * D;
          float* ss2 = (float*)(ws + WS_SS) + (size_t)(l * 2 + 1) * MR;
          { EpiRes<true> E{load_params().out, modl + 2 * D, gvl, (bf16*)(ws + WS_XR), ss2, nullptr, nullptr, nullptr}; pg8::gemm_phase<CF>(ldsl, g, S, E, wv); }
          if constexpr (!last) ctx_gemm<D, D, 1>(wv, lds, (const bf16*)(ws + WS_VB) + (size_t)SEQ * D, (const bf16*)(ws + WS_WOUT), nullptr, nullptr, nullptr, (float*)(ws + WS_XC), modl + NMOD + 2 * D, gvl + 2 * D, (bf16*)(ws + WS_XR), ss2); }
        GRID_BAR();
        { unsigned char* ws = load_params().ws; typedef pg8::Cfg<D, D, 16, 1 << 30, -1, 0> CF; pg8::Gemm g{(const bf16*)(ws + WS_XR), (const bf16*)(ws + WS_XR), (const bf16*)(ws + WS_WGU)};
          pg8::StaticOrder S; S.init(mr, 2 * FF, C.G, C.bid);
          EpiFfn E{(bf16*)(ws + WS_HID), (const float*)(ws + WS_SS) + (size_t)(l * 2 + 1) * MR, (const float*)(ws + WS_CV) + (size_t)l * 2 * NCV + WIN};
          pg8::gemm_phase<CF>(ldsl, g, S, E, wv);
          if constexpr (!last) { const int nfull = ((mr / 256) * 22) % C.G;
              if (nfull) { if (C.bid >= nfull) mixer_prep(lds, wv, 1, C.bid - nfull, C.G - nfull); }
              else mixer_prep(lds, wv, 1, C.bid, C.G); } }
        GRID_BAR();
        { unsigned char* ws = load_params().ws; typedef pg8::Cfg<FF, FF, 16, 1 << 30, -1, 0> CF; pg8::Gemm g{(const bf16*)(ws + WS_HID), (const bf16*)(ws + WS_HID), (const bf16*)(ws + WS_WD)};
          pg8::StaticOrder S; S.init(SEQ, D, C.G, C.bid);
          const float* modl = (const float*)(ws + WS_MOD) + (size_t)l * 2 * NMOD;
          if constexpr (last) { EpiFinal E{load_params().out, modl + 5 * D, load_params().norm_f_g, (float*)(ws + WS_SS) + (size_t)4 * MR, (unsigned*)(ws + WS_CTL) + 12288}; pg8::gemm_phase<CF>(ldsl, g, S, E, wv); }
          else { const float* gvn = (const float*)(ws + WS_GV) + (size_t)(4 + 0) * D;
              float* ss1 = (float*)(ws + WS_SS) + (size_t)2 * MR;
              EpiRes<true> E{load_params().out, modl + 5 * D, gvn, (bf16*)(ws + WS_XR), ss1, nullptr, nullptr, nullptr};
              pg8::gemm_phase<CF>(ldsl, g, S, E, wv);
              ctx_gemm<FF, FF, 1>(wv, lds, (const bf16*)(ws + WS_HID) + (size_t)SEQ * FF, (const bf16*)(ws + WS_WD), nullptr, nullptr, nullptr, (float*)(ws + WS_XC), modl + NMOD + 5 * D, gvn + 2 * D, (bf16*)(ws + WS_XR), ss1); } }
        if constexpr (!last) GRID_BAR();
}

__global__ void __launch_bounds__(NT, 2) fwd_megakernel(Params Pk) {
    extern __shared__ __attribute__((aligned(16))) unsigned char lds[];
    const int wv = __builtin_amdgcn_readfirstlane((int)threadIdx.x >> 6);
    Ctx C; C.tid = tid_of(wv); C.lane = C.tid & 63; C.wave = wv; C.wv = wv; C.G = gridDim.x; C.bid = blockIdx.x; C.lds = lds; C.ws = Pk.ws;
    PG8_LAS unsigned char* ldsl = (PG8_LAS unsigned char*)lds;
    volatile LAS unsigned* MISC = (volatile LAS unsigned*)(ldsl + MISC_OFF);
    for (int u = C.tid; u < (LDS_BYTES - 131072) / 4; u += NT) ((LAS unsigned*)(ldsl + 131072))[u] = 0u;
    __syncthreads();
    XcdBarrier bar = xcd_barrier_post((unsigned*)(Pk.ws + WS_CTL), MISC + 8, wv);

    phase_setup(C);
    GRID_BAR();
    rows_first(C);
    mixer_prep(lds, wv, 0, C.bid, C.G);
    build_s5_mats(C, 0, C.bid, C.G);
    build_s5_mats(C, 1, C.bid, C.G);
    GRID_BAR();

    layer_body<0>(C, lds, ldsl, wv, bar);
    layer_body<1>(C, lds, ldsl, wv, bar);
}

extern "C" void kernel_launch(void* const* d_in, const int* in_sizes, int n_in, void* d_out, int out_size, void* d_ws, size_t ws_size, hipStream_t stream) {
    static int grid = 0;
    if (grid == 0) {
        if (n_in != 29 || out_size != SEQ * D || ws_size < WS_END) { fprintf(stderr, "kernel_launch: unexpected shapes (n_in %d out %d ws %zu)\n", n_in, out_size, ws_size); grid = -1; return; }
        int dev = 0, cus = 0, per_cu = 0;
        if (hipGetDevice(&dev) != hipSuccess || hipDeviceGetAttribute(&cus, hipDeviceAttributeMultiprocessorCount, dev) != hipSuccess) { grid = -1; return; }
        if (hipFuncSetAttribute((const void*)fwd_megakernel, hipFuncAttributeMaxDynamicSharedMemorySize, LDS_BYTES) != hipSuccess) { fprintf(stderr, "kernel_launch: hipFuncSetAttribute failed\n"); grid = -1; return; }
        if (hipOccupancyMaxActiveBlocksPerMultiprocessor(&per_cu, (const void*)fwd_megakernel, NT, LDS_BYTES) != hipSuccess || per_cu < 1) { fprintf(stderr, "kernel_launch: occupancy query says %d\n", per_cu); per_cu = 1; }
        (void)hipGetLastError();
        grid = cus;
    }
    if (grid < 0) return;
    (void)hipMemsetAsync((char*)d_ws + WS_CTL, 0, 64 * 1024, stream);
    Params p{};
    const float** pp = (const float**)&p;
    for (int i = 0; i < 29; ++i) pp[i] = (const float*)d_in[i];
    p.out = (float*)d_out; p.ws = (unsigned char*)d_ws;
    hipLaunchKernelGGL(fwd_megakernel, dim3(grid), dim3(NT), LDS_BYTES, stream, p);
}
```

```cpp
#include <hip/hip_runtime.h>
#include <cstdio>
#include <cstdint>

namespace pg8 {
#define PG8_LAS __attribute__((address_space(3)))
typedef unsigned short bf16_t;
typedef short bf16x8 __attribute__((ext_vector_type(8)));
typedef float f32x4 __attribute__((ext_vector_type(4)));
typedef unsigned u32x4 __attribute__((ext_vector_type(4)));
constexpr int BM = 256, BK = 64, HALF = 128, HTB = HALF * BK * 2, STAGE_BYTES = 8 * HTB, NXCD = 8, WGM = 8;

__host__ __device__ __forceinline__ int lds_byte(int r, int c) { const int st = (r >> 4) * 2 + (c >> 5), rr = r & 15, cc = c & 31, ob = rr * 64 + cc * 2; return st * 1024 + (ob ^ (((ob >> 9) & 1) << 5)); }
__host__ __device__ __forceinline__ void stage_rc(int b, int& R, int& C) { const int st = b / 1024, sb = b % 1024, swz = sb ^ (((sb >> 9) & 1) << 5); R = (st >> 1) * 16 + swz / 64; C = (st & 1) * 32 + (swz % 64) / 2; }
__host__ __device__ __forceinline__ int perm32(int rho) { const int n = rho >> 4, i = rho & 15; return 8 * (i >> 2) + 4 * n + (i & 3); }

struct Unit { int pm, pn; };
struct Gemm { const bf16_t* A; const bf16_t* A2; const bf16_t* Bt; };
template <int K_, int LDA_, int JS_, int TSPLIT_, int TMID_, int APN_> struct Cfg { static constexpr int K = K_, lda = LDA_, jstride = JS_, tsplit = TSPLIT_, tmid = TMID_, apn = APN_; };

struct StaticOrder {
    int nM, nN, nwg, G, c;
    __host__ __device__ void init(int M, int N, int G_, int c_) { nM = M / BM; nN = N / BM; nwg = nM * nN; G = G_; c = c_; }
    __host__ __device__ bool next(int i, Unit& u) const {
        const long L = (long)i * G + c; if (L >= nwg) return false;
        int wgid = (int)L; { const int q = nwg / NXCD, r = nwg % NXCD, xcd = wgid % NXCD, off = wgid / NXCD; wgid = (xcd < r ? xcd * (q + 1) : r * (q + 1) + (xcd - r) * q) + off; }
        const int nig = WGM * nN, gid = wgid / nig, fm = gid * WGM, gsz = (nM - fm) < WGM ? (nM - fm) : WGM;
        u.pm = fm + ((wgid % nig) % gsz); u.pn = (wgid % nig) / gsz; return true;
    }
};

__device__ __forceinline__ unsigned cvt_pk_bf16(float lo, float hi) { unsigned r; asm volatile("v_cvt_pk_bf16_f32 %0, %1, %2" : "=v"(r) : "v"(lo), "v"(hi)); return r; }

template <class CF, class Epi, class Sched>
__device__ __forceinline__ void gemm_phase(PG8_LAS unsigned char* lds, const Gemm g, const Sched& S, const Epi& E, int wv) {
    int tid_; asm volatile("v_mbcnt_lo_u32_b32 %0, -1, 0\n\tv_mbcnt_hi_u32_b32 %0, -1, %0" : "=v"(tid_)); tid_ += wv * 64; asm volatile("" : "+v"(tid_));
    const int tid = tid_, wid = __builtin_amdgcn_readfirstlane(tid >> 6), lane = tid & 63, wr = wid >> 2, wc = wid & 3, fr = lane & 15, fq = lane >> 4;
    constexpr int K = CF::K, nt = K / BK, tsplit = CF::tsplit;
    unsigned voffA[2], voffB[2];
#pragma unroll
    for (int i = 0; i < 2; ++i) { int R, C; stage_rc(tid * 16 + i * 8192, R, C); const int Rb = Epi::PERM ? ((R & ~31) + perm32(R & 31)) : R;
        voffA[i] = (unsigned)(R * CF::lda + (C >> 4) * CF::jstride + (C & 15)) * 2u; voffB[i] = (unsigned)(Rb * K + C) * 2u; }
    constexpr size_t kstepA = (size_t)CF::jstride * 8, kstepB = (size_t)(BK * 2);
    constexpr size_t hstepA = (size_t)HALF * CF::lda * 2, hstepB = (size_t)HALF * K * 2;
    constexpr size_t tstepA = 2 * hstepA, tstepB = 2 * hstepB, apnb = (size_t)CF::apn * 2;
    const unsigned ldsw = (unsigned)wid * 1024u;
    const int aoff = lds_byte(wr * 64 + fr, fq * 8), boff = lds_byte(wc * 32 + fr, fq * 8);
#define PG8_SA(b, h) (((b) * 2 + (h)) * HTB)
#define PG8_SB(b, h) ((4 + (b) * 2 + (h)) * HTB)
#define PG8_STAGE(bufoff, gbase, voff) do { _Pragma("unroll") for (int _i = 0; _i < 2; ++_i) \
        __builtin_amdgcn_global_load_lds((const unsigned*)((const char*)(gbase) + (voff)[_i]), (PG8_LAS unsigned*)(lds + (bufoff) + ldsw + _i * 8192), 16, 0, 0); } while (0)
#define PG8_LDA(dst, b, h) do { _Pragma("unroll") for (int m = 0; m < 4; ++m) _Pragma("unroll") for (int k = 0; k < 2; ++k) dst[m][k] = *(const PG8_LAS bf16x8*)(lds + PG8_SA(b, h) + aoff + m * 2048 + k * 1024); } while (0)
#define PG8_LDB(dst, b, h) do { _Pragma("unroll") for (int n = 0; n < 2; ++n) _Pragma("unroll") for (int k = 0; k < 2; ++k) dst[n][k] = *(const PG8_LAS bf16x8*)(lds + PG8_SB(b, h) + boff + n * 2048 + k * 1024); } while (0)
#define PG8_MMA(ai, bj, At, Bt) do { __builtin_amdgcn_s_setprio(1); _Pragma("unroll") for (int m = 0; m < 4; ++m) _Pragma("unroll") for (int n = 0; n < 2; ++n) _Pragma("unroll") for (int k = 0; k < 2; ++k) \
        acc[ai][bj][m][n] = __builtin_amdgcn_mfma_f32_16x16x32_bf16(Bt[n][k], At[m][k], acc[ai][bj][m][n], 0, 0, 0); __builtin_amdgcn_s_setprio(0); } while (0)
#define PG8_WAIT_V(n) asm volatile("s_waitcnt vmcnt(" #n ")" ::: "memory")
#define PG8_WAIT_L(n) asm volatile("s_waitcnt lgkmcnt(" #n ")" ::: "memory")
#define PG8_BAR __builtin_amdgcn_s_barrier()
#define PG8_SCHED __builtin_amdgcn_sched_barrier(0)
#define PG8_UA(u)  ((const char*)g.A  + (size_t)(u).pm * tstepA + (size_t)(u).pn * apnb)
#define PG8_UA2(u) ((const char*)g.A2 + (size_t)(u).pm * tstepA + (size_t)(u).pn * apnb - (size_t)tsplit * kstepA)
    Unit cur, nxt; int ui = 0;
    if (!S.next(0, cur)) return;
    f32x4 acc[2][2][4][2];
#pragma unroll
    for (int a = 0; a < 2; ++a)
#pragma unroll
        for (int b = 0; b < 2; ++b)
#pragma unroll
            for (int m = 0; m < 4; ++m)
#pragma unroll
                for (int n = 0; n < 2; ++n) acc[a][b][m][n] = (f32x4){0.f, 0.f, 0.f, 0.f};
    bf16x8 At[4][2], B0[2][2], B1[2][2];
    const char* cA = PG8_UA(cur); const char* cA2 = PG8_UA2(cur); const char* cB = (const char*)g.Bt + (size_t)cur.pn * tstepB;
    PG8_STAGE(PG8_SB(0, 0), cB, voffB); PG8_STAGE(PG8_SB(0, 1), cB + hstepB, voffB); PG8_STAGE(PG8_SA(0, 0), cA, voffA); PG8_STAGE(PG8_SA(0, 1), cA + hstepA, voffA);
    if (wr == 1) PG8_BAR;
    PG8_WAIT_V(2); PG8_BAR;
    PG8_STAGE(PG8_SB(1, 0), cB + kstepB, voffB); PG8_STAGE(PG8_SA(1, 0), cA + kstepA, voffA); PG8_STAGE(PG8_SB(1, 1), cB + hstepB + kstepB, voffB);
    PG8_WAIT_V(6); PG8_BAR;
    for (;;) {
        const bool has_next = S.next(ui + 1, nxt);
        const char* nA = has_next ? PG8_UA(nxt) : cA; const char* nB = has_next ? (const char*)g.Bt + (size_t)nxt.pn * tstepB : cB;
        for (int t = 0; t < nt; t += 2) {
            if constexpr (Epi::MID) { if (t == CF::tmid) E.mid(acc, cur, wr, wc, fr, fq); }
            const bool last = (t == nt - 2);
            const char* a1 = ((t + 1 < tsplit) ? cA : cA2) + (size_t)(t + 1) * kstepA;
            const char* a2 = last ? nA : ((t + 2 < tsplit) ? cA : cA2) + (size_t)(t + 2) * kstepA;
            const char* b2 = last ? nB : cB + (size_t)(t + 2) * kstepB;
            const char* a3 = a2 + kstepA; const char* b3 = b2 + kstepB;
            PG8_LDB(B0, 0, 0); PG8_LDB(B1, 0, 1); PG8_SCHED; PG8_LDA(At, 0, 0); PG8_STAGE(PG8_SA(1, 1), a1 + hstepA, voffA);
            PG8_WAIT_V(8); PG8_WAIT_L(0); PG8_BAR; PG8_MMA(0, 0, At, B0); PG8_MMA(0, 1, At, B1); PG8_BAR; PG8_SCHED;
            PG8_LDA(At, 0, 1); PG8_STAGE(PG8_SB(0, 0), b2, voffB); PG8_STAGE(PG8_SB(0, 1), b2 + hstepB, voffB); PG8_STAGE(PG8_SA(0, 0), a2, voffA);
            PG8_WAIT_V(8); PG8_WAIT_L(0); PG8_BAR; PG8_MMA(1, 0, At, B0); PG8_MMA(1, 1, At, B1); PG8_BAR; PG8_SCHED;
            PG8_LDB(B0, 1, 0); PG8_LDB(B1, 1, 1); PG8_SCHED; PG8_LDA(At, 1, 0); PG8_STAGE(PG8_SA(0, 1), a2 + hstepA, voffA);
            PG8_WAIT_V(8); PG8_WAIT_L(0); PG8_BAR; PG8_MMA(0, 0, At, B0); PG8_MMA(0, 1, At, B1); PG8_BAR; PG8_SCHED;
            PG8_LDA(At, 1, 1); PG8_STAGE(PG8_SB(1, 0), b3, voffB); PG8_STAGE(PG8_SB(1, 1), b3 + hstepB, voffB); PG8_STAGE(PG8_SA(1, 0), a3, voffA);
            PG8_WAIT_V(8); PG8_WAIT_L(0); PG8_BAR; PG8_MMA(1, 0, At, B0); PG8_MMA(1, 1, At, B1); PG8_BAR; PG8_SCHED;
        }
        if (wr == 0) PG8_BAR;
        E(acc, cur, wr, wc, fr, fq);
        if (!has_next) break;
#pragma unroll
        for (int a = 0; a < 2; ++a)
#pragma unroll
            for (int b = 0; b < 2; ++b)
#pragma unroll
                for (int m = 0; m < 4; ++m)
#pragma unroll
                    for (int n = 0; n < 2; ++n) acc[a][b][m][n] = (f32x4){0.f, 0.f, 0.f, 0.f};
        cur = nxt; cA = nA; cA2 = PG8_UA2(cur); cB = nB; ++ui;
        if (wr == 1) PG8_BAR;
    }
    PG8_WAIT_V(0);
    PG8_BAR;
#undef PG8_SA
#undef PG8_SB
#undef PG8_STAGE
#undef PG8_LDA
#undef PG8_LDB
#undef PG8_MMA
#undef PG8_WAIT_V
#undef PG8_WAIT_L
#undef PG8_BAR
#undef PG8_SCHED
#undef PG8_UA
#undef PG8_UA2
}
}

constexpr int NWAVES = 8, NT = NWAVES * 64;
constexpr int D = 1024, SEQ = 16384, CTXN = 256, MR = SEQ + CTXN  ;
constexpr int SSMW = 512, NG = 32, NP = 64, FF = 2816, WIN = 4608, NMOD = 6 * D;
constexpr int NCH = MR / 16  , NCHP = 1280  ;
constexpr float EPS = 1e-6f;
constexpr size_t MiB = 1u << 20;
constexpr size_t WS_CTL = 0;
constexpr size_t WS_MOD = 64 * 1024;
constexpr size_t WS_A16 = 192 * 1024;
constexpr size_t WS_POSR = 256 * 1024, WS_POSC = 768 * 1024 + 0;
constexpr size_t WS_XC = 1 * MiB;
constexpr size_t WS_APOW = 2 * MiB;
constexpr size_t WS_BTC = 3 * MiB + 256 * 1024;
constexpr size_t WS_SS = 4 * MiB + 512 * 1024;
constexpr size_t WS_CV = 5 * MiB;
constexpr size_t WS_GV = 5 * MiB + 512 * 1024;
constexpr int NCV = WIN + 2 * FF;
constexpr size_t WS_WIN = 6 * MiB, WS_WGLU = 15 * MiB, WS_WPROJ = 15 * MiB + 512 * 1024, WS_WOUT = 18 * MiB + 512 * 1024;
constexpr size_t WS_BAM = 20 * MiB + 512 * 1024, WS_TC = 24 * MiB + 512 * 1024;
constexpr size_t WS_XR = 32 * MiB + 512 * 1024;
constexpr size_t WS_U = 65 * MiB, WS_HST = 81 * MiB + 256 * 1024;
constexpr size_t WS_WGU = 65 * MiB, WS_WD = 76 * MiB;
constexpr size_t WS_VB = 97 * MiB + 512 * 1024;
constexpr size_t WS_SA = 130 * MiB, WS_SB = 162 * MiB + 512 * 1024;
constexpr size_t WS_A2 = 195 * MiB;
constexpr size_t WS_HID = WS_VB;
constexpr size_t WS_BAM1 = 244 * MiB, WS_TC1 = 248 * MiB;
constexpr size_t WS_END = 256 * MiB;
static_assert(WS_HID + (size_t)MR * FF * 2 <= WS_A2, "hid overlay");
static_assert(WS_A2 + (size_t)MR * 1536 * 2 <= WS_END, "a2");
static_assert(WS_WD + (size_t)D * FF * 2 <= WS_VB, "wd");
static_assert(WS_BTC + 8192 * 32 * 4 <= WS_WIN && WS_APOW + 8192 * 34 * 4 <= WS_BTC, "small");

constexpr int LDS_BYTES = 147456, MISC_OFF = 131072 + 320;

#define LAS __attribute__((address_space(3)))
__device__ __forceinline__ int lane_id_v() { int l; asm volatile("v_mbcnt_lo_u32_b32 %0, -1, 0\n\tv_mbcnt_hi_u32_b32 %0, -1, %0" : "=v"(l)); return l; }
__device__ __forceinline__ int tid_of(int wv) { return wv * 64 + lane_id_v(); }
typedef unsigned short bf16;
typedef unsigned v4u __attribute__((ext_vector_type(4)));
typedef unsigned v2u __attribute__((ext_vector_type(2)));
typedef float f32x4 __attribute__((ext_vector_type(4)));
typedef float f32x2 __attribute__((ext_vector_type(2)));
using pg8::cvt_pk_bf16;

__device__ __forceinline__ float bf_lo(unsigned u) { return __uint_as_float(u << 16); }
__device__ __forceinline__ float bf_hi(unsigned u) { return __uint_as_float(u & 0xffff0000u); }
__device__ __forceinline__ unsigned f2bf(float f) { unsigned u = __float_as_uint(f); return (u + 0x7fffu + ((u >> 16) & 1u)) >> 16; }
__device__ __forceinline__ float sigm(float x) { return __builtin_amdgcn_rcpf(1.0f + __expf(-x)); }
__device__ __forceinline__ float silu_f(float x) { return x * sigm(x); }
__device__ __forceinline__ float gelu_tanh(float x) { return x * sigm(1.5957691216057308f * (x + 0.044715f * x * x * x)); }
__device__ __forceinline__ float wave_sum(float v) {
#pragma unroll
    for (int o = 1; o < 64; o <<= 1) v += __shfl_xor(v, o);
    return v;
}
__device__ __forceinline__ void sincos_cw(float x, float& s, float& c) {
    const float kf = rintf(x * 0.63661977236758134f);
    float r = fmaf(-kf, 1.5703125f, x); r = fmaf(-kf, 4.837512969970703125e-4f, r); r = fmaf(-kf, 7.54978995489188216e-8f, r);
    const float r2 = r * r;
    float sp = fmaf(r2, 2.7557319e-6f, -1.9841270e-4f); sp = fmaf(sp, r2, 8.3333333e-3f); sp = fmaf(sp, r2, -1.6666667e-1f); sp = fmaf(sp * r2, r, r);
    float cp = fmaf(r2, -2.7557319e-7f, 2.4801587e-5f); cp = fmaf(cp, r2, -1.3888889e-3f); cp = fmaf(cp, r2, 4.1666667e-2f); cp = fmaf(cp, r2, -0.5f); cp = fmaf(cp, r2, 1.0f);
    const int q = ((int)kf) & 3;
    const float ss = (q & 1) ? cp : sp, cc = (q & 1) ? sp : cp;
    s = (q & 2) ? -ss : ss; c = ((q + 1) & 2) ? -cc : cc;
}

struct Params {
    const float *x, *c, *ctx, *c_ctx, *w_mod, *b_mod, *norm1_g, *norm2_g, *w_in, *lam_re, *lam_im, *log_step, *b_re, *b_im, *c_re, *c_im, *ssm_d,
        *w_glu, *w_proj_a, *dw_kernel, *dw_bias, *cn_g, *cn_b, *w_proj_b, *w_out, *w_gate, *w_up, *w_down, *norm_f_g;
    float* out; unsigned char* ws;
};
__device__ __forceinline__ Params load_params() {
    Params p{};
#if defined(__HIP_DEVICE_COMPILE__)
    typedef const void* cvp;
    const __attribute__((address_space(4))) cvp* kp = (const __attribute__((address_space(4))) cvp*)__builtin_amdgcn_kernarg_segment_ptr(); asm volatile("" : "+s"(kp));
    cvp* dst = (cvp*)&p;
#pragma unroll
    for (int i = 0; i < 31; ++i) dst[i] = kp[i];
#endif
    return p;
}

#define XB_TMO      128
#define XB_XCNT(j)  (256  + 64 * (j))
#define XB_XSUB(j)  (1280 + 64 * (j))
#define XB_XGEN(j)  (2304 + 64 * (j))
#define XB_TOP      3328
#define XB_TOPGEN   3392
#define XCD_BAR_WORDS 3456
#define XB_SPIN_CAP (1u << 18)
__device__ __forceinline__ unsigned xb_ld(unsigned* p)              { return __hip_atomic_load(p, __ATOMIC_RELAXED, __HIP_MEMORY_SCOPE_AGENT); }
__device__ __forceinline__ unsigned xb_add(unsigned* p, unsigned v) { return __hip_atomic_fetch_add(p, v, __ATOMIC_RELAXED, __HIP_MEMORY_SCOPE_AGENT); }
__device__ __forceinline__ unsigned xb_xcc_id() { return (unsigned)__builtin_amdgcn_s_getreg((3 << 11) | 20) & 0xFu; }
#define XB_SPIN(cond, bar) do { unsigned _sp = 0; while (cond) { __builtin_amdgcn_s_sleep(1); \
    if ((++_sp & 255u) == 0u) { if (xb_ld(&(bar)[XB_TMO])) break; if (_sp > XB_SPIN_CAP) { atomicAdd(&(bar)[XB_TMO], 1u); break; } } } } while (0)
struct XcdBarrier { unsigned* bar; unsigned x; volatile LAS unsigned* st; int wv; };
__device__ __forceinline__ XcdBarrier xcd_barrier_post(unsigned* bar, volatile LAS unsigned* st, int wv) {
    XcdBarrier b; b.bar = bar; b.x = xb_xcc_id(); b.st = st; b.wv = wv;
    if (tid_of(wv) == 0) (void)xb_add(&bar[XB_XCNT(b.x)], 1u);
    return b;
}
__device__ __forceinline__ void xcd_barrier_complete(unsigned* bar, unsigned x, unsigned& nloc, unsigned& nx) {
    const unsigned G = gridDim.x * gridDim.y * gridDim.z;
    unsigned sum, cnt, mine, sp = 0u;
    for (;;) {
        sum = 0u; cnt = 0u; mine = 0u;
#pragma unroll
        for (unsigned j = 0; j < 16; ++j) { const unsigned c = xb_ld(&bar[XB_XCNT(j)]); sum += c; cnt += (c > 0u) ? 1u : 0u; mine = (j == x) ? c : mine; }
        if (sum == G) break;
        __builtin_amdgcn_s_sleep(1);
        if ((++sp & 255u) == 0u) { if (xb_ld(&bar[XB_TMO])) break; if (sp > XB_SPIN_CAP) { atomicAdd(&bar[XB_TMO], 1u); break; } }
    }
    nloc = mine > 0u ? mine : 1u; nx = cnt > 0u ? cnt : 1u;
}
__device__ __forceinline__ void xcd_barrier(const XcdBarrier& b0) {
    asm volatile("s_waitcnt vmcnt(0)" ::: "memory");
    __syncthreads();
    if (tid_of(b0.wv) == 0) {
        XcdBarrier b; b.bar = (unsigned*)(load_params().ws + WS_CTL); b.x = xb_xcc_id(); b.st = b0.st;
        unsigned* bar = b.bar;
        __builtin_amdgcn_s_waitcnt(0);
        unsigned nloc = b.st[0], nx = b.st[1];
        if (nloc == 0u) { xcd_barrier_complete(bar, b.x, nloc, nx); b.st[0] = nloc; b.st[1] = nx; }
        const unsigned old = xb_add(&bar[XB_XSUB(b.x)], 1u);
        const unsigned gen = old / nloc;
        if (old + 1u == (gen + 1u) * nloc) {
            __builtin_amdgcn_fence(__ATOMIC_RELEASE, "agent");
            asm volatile("s_waitcnt vmcnt(0)" ::: "memory");
            const unsigned og = xb_add(&bar[XB_TOP], 1u);
            const unsigned tg = og / nx;
            if (og + 1u == (tg + 1u) * nx) xb_add(&bar[XB_TOPGEN], 1u);
            else XB_SPIN(xb_ld(&bar[XB_TOPGEN]) == tg, bar);
            __builtin_amdgcn_fence(__ATOMIC_ACQUIRE, "agent");
            xb_add(&bar[XB_XGEN(b.x)], 1u);
            asm volatile("s_waitcnt vmcnt(0)" ::: "memory");
        } else {
            XB_SPIN(xb_ld(&bar[XB_XGEN(b.x)]) == gen, bar);
            __builtin_amdgcn_fence(__ATOMIC_ACQUIRE, "agent");
            asm volatile("s_waitcnt vmcnt(0)" ::: "memory");
        }
    }
    __syncthreads();
}

typedef pg8::f32x4 (AccT)[2][2][4][2];
#define FOR_AI_M _Pragma("unroll") for (int ai = 0; ai < 2; ++ai) _Pragma("unroll") for (int m = 0; m < 4; ++m)

struct EpiWin {
    static constexpr bool PERM = true, MID = false;
    bf16 *U, *VB, *SA, *SB; const float* SS; const float* CV;
    __device__ __forceinline__ void operator()(const AccT& acc, const pg8::Unit& u, int wr, int wc, int fr, int fq) const {
        const int row0 = u.pm * 256 + wr * 64 + fr, cl = wc * 32 + 8 * fq;
        const float* cv = CV + (u.pm >= 64 ? NCV : 0) + u.pn * 256 + cl;
        f32x4 c00 = *(const f32x4*)(cv), c01 = *(const f32x4*)(cv + 4), c10 = *(const f32x4*)(cv + 128), c11 = *(const f32x4*)(cv + 132);
        float rsv[2][4];
        FOR_AI_M rsv[ai][m] = SS[row0 + ai * 128 + m * 16];
        FOR_AI_M rsv[ai][m] = rsqrtf(rsv[ai][m] * (1.0f / D) + EPS);
        if (u.pn >= 2 && u.pn < 10) {
            FOR_AI_M { const int row = row0 + ai * 128 + m * 16; const float rs = rsv[ai][m];
                const f32x4 v0 = acc[ai][0][m][0] * rs + c00, v1 = acc[ai][0][m][1] * rs + c01, g0 = acc[ai][1][m][0] * rs + c10, g1 = acc[ai][1][m][1] * rs + c11;
                v4u w; w.x = cvt_pk_bf16(v0[0] * sigm(g0[0]), v0[1] * sigm(g0[1])); w.y = cvt_pk_bf16(v0[2] * sigm(g0[2]), v0[3] * sigm(g0[3]));
                w.z = cvt_pk_bf16(v1[0] * sigm(g1[0]), v1[1] * sigm(g1[1])); w.w = cvt_pk_bf16(v1[2] * sigm(g1[2]), v1[3] * sigm(g1[3]));
                *(v4u*)(VB + (size_t)row * 1024 + (u.pn - 2) * 128 + cl) = w; }
        } else {
            bf16* base; int ldc, colt; bool sg;
            if (u.pn < 2) { base = U; ldc = 512; colt = u.pn * 256; sg = false; }
            else if (u.pn < 14) { base = SA; ldc = 1024; colt = (u.pn - 10) * 256; sg = true; }
            else { base = SB; ldc = 1024; colt = (u.pn - 14) * 256; sg = true; }
            FOR_AI_M { const int row = row0 + ai * 128 + m * 16; const float rs = rsv[ai][m];
#pragma unroll
                for (int bj = 0; bj < 2; ++bj) { f32x4 v0 = acc[ai][bj][m][0] * rs + (bj ? c10 : c00), v1 = acc[ai][bj][m][1] * rs + (bj ? c11 : c01);
                    if (sg) { for (int i = 0; i < 4; ++i) { v0[i] = sigm(v0[i]); v1[i] = sigm(v1[i]); } }
                    v4u w; w.x = cvt_pk_bf16(v0[0], v0[1]); w.y = cvt_pk_bf16(v0[2], v0[3]); w.z = cvt_pk_bf16(v1[0], v1[1]); w.w = cvt_pk_bf16(v1[2], v1[3]);
                    *(v4u*)(base + (size_t)row * ldc + colt + bj * 128 + cl) = w; } }
        }
    }
};
struct EpiS1 {
    static constexpr bool PERM = false, MID = false;
    float* S;
    __device__ __forceinline__ void operator()(const AccT& acc, const pg8::Unit& u, int wr, int wc, int fr, int fq) const {
        float* sp = S + (size_t)(u.pm * 256 + wr * 64 + fr) * 8192 + u.pn * 256 + wc * 32 + 4 * fq;
        if (u.pm < 4) {
            FOR_AI_M {
#pragma unroll
                for (int bj = 0; bj < 2; ++bj)
#pragma unroll
                    for (int n = 0; n < 2; ++n) *(f32x4*)(sp + (size_t)(ai * 128 + m * 16) * 8192 + bj * 128 + n * 16) = acc[ai][bj][m][n]; asm volatile("" ::: "memory"); }
        } else if (wr == 0) {
#pragma unroll
            for (int bj = 0; bj < 2; ++bj)
#pragma unroll
                for (int n = 0; n < 2; ++n) *(f32x4*)(sp + bj * 128 + n * 16) = acc[0][bj][0][n];
        }
    }
};
struct EpiS3 {
    static constexpr bool PERM = true, MID = false;
    bf16* YA;
    __device__ __forceinline__ void operator()(const AccT& acc, const pg8::Unit& u, int wr, int wc, int fr, int fq) const {
        const int row0 = u.pm * 256 + wr * 64 + fr;
        FOR_AI_M { const int chunk = row0 + ai * 128 + m * 16;
#pragma unroll
            for (int bj = 0; bj < 2; ++bj) { const int col8 = bj * 128 + wc * 32 + 8 * fq, t = col8 >> 4, ch = u.pn * 16 + (col8 & 15);
                const f32x4 a0 = acc[ai][bj][m][0], a1 = acc[ai][bj][m][1];
                v4u w; w.x = cvt_pk_bf16(gelu_tanh(a0[0]), gelu_tanh(a0[1])); w.y = cvt_pk_bf16(gelu_tanh(a0[2]), gelu_tanh(a0[3]));
                w.z = cvt_pk_bf16(gelu_tanh(a1[0]), gelu_tanh(a1[1])); w.w = cvt_pk_bf16(gelu_tanh(a1[2]), gelu_tanh(a1[3]));
                *(v4u*)(YA + (size_t)(chunk * 16 + t) * 512 + ch) = w; } asm volatile("" ::: "memory"); }
    }
};
struct EpiGlu {
    static constexpr bool PERM = true, MID = false;
    const bf16* YA; bf16* A2;
    __device__ __forceinline__ void operator()(const AccT& acc, const pg8::Unit& u, int wr, int wc, int fr, int fq) const {
        const int row0 = u.pm * 256 + wr * 64 + fr, col0 = u.pn * 256 + wc * 32 + 8 * fq;
        v4u yv[2][4][2];
        FOR_AI_M { const int row = row0 + ai * 128 + m * 16;
#pragma unroll
            for (int bj = 0; bj < 2; ++bj) yv[ai][m][bj] = *(const v4u*)(YA + (size_t)row * 512 + col0 + bj * 128); }
        FOR_AI_M { const int row = row0 + ai * 128 + m * 16;
#pragma unroll
            for (int bj = 0; bj < 2; ++bj) { const int col = col0 + bj * 128; const v4u y = yv[ai][m][bj]; const f32x4 a0 = acc[ai][bj][m][0], a1 = acc[ai][bj][m][1];
                v4u w; w.x = cvt_pk_bf16(bf_lo(y.x) * sigm(a0[0]), bf_hi(y.x) * sigm(a0[1])); w.y = cvt_pk_bf16(bf_lo(y.y) * sigm(a0[2]), bf_hi(y.y) * sigm(a0[3]));
                w.z = cvt_pk_bf16(bf_lo(y.z) * sigm(a1[0]), bf_hi(y.z) * sigm(a1[1])); w.w = cvt_pk_bf16(bf_lo(y.w) * sigm(a1[2]), bf_hi(y.w) * sigm(a1[3]));
                *(v4u*)(A2 + (size_t)row * 1536 + col) = w; } }
    }
};
struct EpiMerged {
    static constexpr bool PERM = true, MID = true;
    const bf16 *SA, *SB; bf16* MG;
    __device__ __forceinline__ void mid(AccT& acc, const pg8::Unit& u, int wr, int wc, int fr_, int fq_) const {
        int fr = fr_, fq = fq_; asm volatile("" : "+v"(fr), "+v"(fq));
        const int row0 = u.pm * 256 + wr * 64 + fr, col0 = u.pn * 256 + wc * 32 + 8 * fq;
        FOR_AI_M { const int row = row0 + ai * 128 + m * 16;
#pragma unroll
            for (int bj = 0; bj < 2; ++bj) { const size_t off = (size_t)row * 1024 + col0 + bj * 128; const v4u a = *(const v4u*)(SA + off), b = *(const v4u*)(SB + off);
                f32x4& a0 = acc[ai][bj][m][0]; f32x4& a1 = acc[ai][bj][m][1];
                a0[0] *= bf_lo(a.x) * __builtin_amdgcn_rcpf(bf_lo(b.x)); a0[1] *= bf_hi(a.x) * __builtin_amdgcn_rcpf(bf_hi(b.x));
                a0[2] *= bf_lo(a.y) * __builtin_amdgcn_rcpf(bf_lo(b.y)); a0[3] *= bf_hi(a.y) * __builtin_amdgcn_rcpf(bf_hi(b.y));
                a1[0] *= bf_lo(a.z) * __builtin_amdgcn_rcpf(bf_lo(b.z)); a1[1] *= bf_hi(a.z) * __builtin_amdgcn_rcpf(bf_hi(b.z));
                a1[2] *= bf_lo(a.w) * __builtin_amdgcn_rcpf(bf_lo(b.w)); a1[3] *= bf_hi(a.w) * __builtin_amdgcn_rcpf(bf_hi(b.w)); } asm volatile("" ::: "memory"); }
    }
    __device__ __forceinline__ void operator()(const AccT& acc, const pg8::Unit& u, int wr, int wc, int fr, int fq) const {
        const int row0 = u.pm * 256 + wr * 64 + fr, col0 = u.pn * 256 + wc * 32 + 8 * fq;
        v4u bv[2][4][2];
        FOR_AI_M { const int row = row0 + ai * 128 + m * 16;
#pragma unroll
            for (int bj = 0; bj < 2; ++bj) bv[ai][m][bj] = *(const v4u*)(SB + (size_t)row * 1024 + col0 + bj * 128); }
        FOR_AI_M { const int row = row0 + ai * 128 + m * 16;
#pragma unroll
            for (int bj = 0; bj < 2; ++bj) { const size_t off = (size_t)row * 1024 + col0 + bj * 128; const v4u b = bv[ai][m][bj]; const f32x4 a0 = acc[ai][bj][m][0], a1 = acc[ai][bj][m][1];
                v4u w; w.x = cvt_pk_bf16(a0[0] * bf_lo(b.x), a0[1] * bf_hi(b.x)); w.y = cvt_pk_bf16(a0[2] * bf_lo(b.y), a0[3] * bf_hi(b.y));
                w.z = cvt_pk_bf16(a1[0] * bf_lo(b.z), a1[1] * bf_hi(b.z)); w.w = cvt_pk_bf16(a1[2] * bf_lo(b.w), a1[3] * bf_hi(b.w));
                *(v4u*)(MG + off) = w; } }
    }
};
template <bool XG, bool FIRST = false> struct EpiRes {
    static constexpr bool PERM = false, MID = false;
    float* X; const float* gate; const float* gv; bf16* XGo; float* SSo; const float* Xin; const float* posr; const float* posc;
    __device__ __forceinline__ void operator()(const AccT& acc, const pg8::Unit& u, int wr, int wc, int fr, int fq) const {
        const int row0 = u.pm * 256 + wr * 64 + fr, col0 = u.pn * 256 + wc * 32 + 4 * fq;
        const float* XL = FIRST ? Xin : X;
        const float* ptab = (u.pn < 2) ? posr + col0 : posc + (col0 - 512);
        f32x4 gg[2][2], gw[2][2];
#pragma unroll
        for (int bj = 0; bj < 2; ++bj)
#pragma unroll
            for (int n = 0; n < 2; ++n) { gg[bj][n] = *(const f32x4*)(gate + col0 + bj * 128 + n * 16); if (XG) gw[bj][n] = *(const f32x4*)(gv + col0 + bj * 128 + n * 16); }
        f32x4 cur[2][2], nxt[2][2];
        { const float* rp = XL + (size_t)row0 * D + col0; const float* pp = ptab + (size_t)((u.pn < 2) ? (row0 >> 6) : (row0 & 63)) * 512;
#pragma unroll
          for (int bj = 0; bj < 2; ++bj)
#pragma unroll
              for (int n = 0; n < 2; ++n) { cur[bj][n] = *(const f32x4*)(rp + bj * 128 + n * 16); if (FIRST) cur[bj][n] += *(const f32x4*)(pp + bj * 128 + n * 16); } }
#pragma unroll
        for (int it = 0; it < 8; ++it) { const int ai = it >> 2, m = it & 3; const int row = row0 + ai * 128 + m * 16; float* rp = X + (size_t)row * D + col0;
            if (it < 7) { const int r2 = row0 + ((it + 1) >> 2) * 128 + ((it + 1) & 3) * 16; const float* rn = XL + (size_t)r2 * D + col0; const float* pp = ptab + (size_t)((u.pn < 2) ? (r2 >> 6) : (r2 & 63)) * 512;
#pragma unroll
                for (int bj = 0; bj < 2; ++bj)
#pragma unroll
                    for (int n = 0; n < 2; ++n) { nxt[bj][n] = *(const f32x4*)(rn + bj * 128 + n * 16); if (FIRST) nxt[bj][n] += *(const f32x4*)(pp + bj * 128 + n * 16); } }
            asm volatile("" ::: "memory");
            float ss = 0.f;
#pragma unroll
            for (int bj = 0; bj < 2; ++bj)
#pragma unroll
                for (int n = 0; n < 2; ++n) { const f32x4 xv = cur[bj][n] + gg[bj][n] * acc[ai][bj][m][n]; *(f32x4*)(rp + bj * 128 + n * 16) = xv;
                    if (XG) { ss += (xv[0] * xv[0] + xv[1] * xv[1]) + (xv[2] * xv[2] + xv[3] * xv[3]); const f32x4 y = xv * gw[bj][n];
                        v2u w; w.x = cvt_pk_bf16(y[0], y[1]); w.y = cvt_pk_bf16(y[2], y[3]); *(v2u*)(XGo + (size_t)row * D + col0 + bj * 128 + n * 16) = w; } }
            if (XG) { ss += __shfl_xor(ss, 16); ss += __shfl_xor(ss, 32); if (fq == 0) atomicAdd(SSo + row, ss); }
            asm volatile("" ::: "memory");
#pragma unroll
            for (int bj = 0; bj < 2; ++bj)
#pragma unroll
                for (int n = 0; n < 2; ++n) cur[bj][n] = nxt[bj][n]; }
    }
};
struct EpiFfn {
    static constexpr bool PERM = true, MID = false;
    bf16* H; const float* SS; const float* CV;
    __device__ __forceinline__ void operator()(const AccT& acc, const pg8::Unit& u, int wr, int wc, int fr, int fq) const {
        const int row0 = u.pm * 256 + wr * 64 + fr, col0 = u.pn * 128 + wc * 32 + 8 * fq;
        const float* cv = CV + (u.pm >= 64 ? NCV : 0) + u.pn * 256 + wc * 32 + 8 * fq;
        const f32x4 c00 = *(const f32x4*)(cv), c01 = *(const f32x4*)(cv + 4), c10 = *(const f32x4*)(cv + 128), c11 = *(const f32x4*)(cv + 132);
        float rsv[2][4];
        FOR_AI_M rsv[ai][m] = SS[row0 + ai * 128 + m * 16];
        FOR_AI_M rsv[ai][m] = rsqrtf(rsv[ai][m] * (1.0f / D) + EPS);
        FOR_AI_M { const int row = row0 + ai * 128 + m * 16; const float rs = rsv[ai][m];
            const f32x4 g0 = acc[ai][0][m][0] * rs + c00, g1 = acc[ai][0][m][1] * rs + c01, u0 = acc[ai][1][m][0] * rs + c10, u1 = acc[ai][1][m][1] * rs + c11;
            v4u w; w.x = cvt_pk_bf16(silu_f(g0[0]) * u0[0], silu_f(g0[1]) * u0[1]); w.y = cvt_pk_bf16(silu_f(g0[2]) * u0[2], silu_f(g0[3]) * u0[3]);
            w.z = cvt_pk_bf16(silu_f(g1[0]) * u1[0], silu_f(g1[1]) * u1[1]); w.w = cvt_pk_bf16(silu_f(g1[2]) * u1[2], silu_f(g1[3]) * u1[3]);
            *(v4u*)(H + (size_t)row * FF + col0) = w; }
    }
};

struct Ctx { int tid, lane, wave, G, bid, wv; unsigned char* lds; unsigned char* ws; };
__device__ __forceinline__ Ctx mkctx(unsigned char* lds, unsigned char* ws, int wv) { Ctx C; C.wv = wv; int t = tid_of(wv); asm volatile("" : "+v"(t)); C.tid = t; C.lane = t & 63; C.wave = __builtin_amdgcn_readfirstlane(t >> 6); C.G = gridDim.x; C.bid = blockIdx.x; asm volatile("" : "+s"(ws)); C.lds = lds; C.ws = ws; return C; }

__device__ __forceinline__ void transpose_item(const float* W, int N, bf16* WT, int ldk, int koff, int drow0, int k0, int n0, float* scr, int lane, const float* sh, float* cvo) {
    { float tv[32]; const float* wp = W + (size_t)(k0 + (lane >> 5)) * N + n0 + (lane & 31);
#pragma unroll
      for (int i = 0; i < 32; ++i) tv[i] = wp[(size_t)(2 * i) * N];
#pragma unroll
      for (int i = 0; i < 32; ++i) scr[(2 * i + (lane >> 5)) * 33 + (lane & 31)] = tv[i]; }
    asm volatile("s_waitcnt lgkmcnt(0)" ::: "memory");
    if (sh) {
        float a0 = 0.f, a1 = 0.f;
#pragma unroll 16
        for (int kk = 0; kk < 64; ++kk) { const float w = scr[kk * 33 + (lane & 31)]; a0 = fmaf(sh[k0 + kk], w, a0); a1 = fmaf(sh[NMOD + k0 + kk], w, a1); }
        if (lane < 32) { atomicAdd(cvo + drow0 + lane, a0); atomicAdd(cvo + NCV + drow0 + lane, a1); }
    }
    const int c = lane & 7;
#pragma unroll
    for (int j = 0; j < 4; ++j) { const int n = (lane >> 3) + 8 * j; const float* s = scr + (8 * c) * 33 + n;
        v4u o; o.x = cvt_pk_bf16(s[0 * 33], s[1 * 33]); o.y = cvt_pk_bf16(s[2 * 33], s[3 * 33]); o.z = cvt_pk_bf16(s[4 * 33], s[5 * 33]); o.w = cvt_pk_bf16(s[6 * 33], s[7 * 33]);
        *(v4u*)(WT + (size_t)(drow0 + n) * ldk + koff + k0 + 8 * c) = o; }
    asm volatile("s_waitcnt lgkmcnt(0)" ::: "memory");
}
__device__ __forceinline__ bool transpose_job(int& it, const float* W, int K, int N, bf16* WT, int ldk, int koff, int mode, float* scr, int lane, const float* sh = nullptr, float* cvo = nullptr) {
    const int nblk = N / 32, items = (K / 64) * nblk;
    if (it >= items) { it -= items; return false; }
    const int kb = it / nblk, nb = it % nblk, n0 = 32 * nb; int dr = n0;
    if (mode == 1) { if (n0 >= 512 && n0 < 1536) { const int c = n0 - 512; dr = 512 + (c >> 7) * 256 + (c & 127); } else if (n0 >= 1536 && n0 < 2560) { const int c = n0 - 1536; dr = 512 + (c >> 7) * 256 + 128 + (c & 127); } }
    else if (mode == 2) dr = (n0 >> 7) * 256 + (n0 & 127);
    else if (mode == 3) dr = (n0 >> 7) * 256 + 128 + (n0 & 127);
    transpose_item(W, N, WT, ldk, koff, dr, 64 * kb, n0, scr, lane, sh, cvo);
    return true;
}

__device__ __forceinline__ void rows_first(const Ctx& C0) {
    const Ctx C = mkctx(C0.lds, C0.ws, C0.wv); const Params P = load_params();
    const int gw = C.bid * NWAVES + C.wave, NGW = C.G * NWAVES, lane = C.lane;
    const float* modl = (const float*)(C.ws + WS_MOD);
    const float* posr = (const float*)(C.ws + WS_POSR); const float* posc = (const float*)(C.ws + WS_POSC);
    float* XC = (float*)(C.ws + WS_XC); float* SS = (float*)(C.ws + WS_SS); bf16* Hout = (bf16*)(C.ws + WS_XR);
    f32x4 gn[4];
#pragma unroll
    for (int j = 0; j < 4; ++j) gn[j] = *(const f32x4*)(P.norm1_g + 4 * lane + 256 * j);
    for (int row = gw; row < MR; row += NGW) {
        const bool isc = row >= SEQ; const float* mv = modl + (isc ? NMOD : 0);
        f32x4 v[4];
        if (isc) {
#pragma unroll
            for (int j = 0; j < 4; ++j) v[j] = *(const f32x4*)(P.ctx + (size_t)(row - SEQ) * D + 4 * lane + 256 * j);
        } else {
            const int pr = row >> 6, pc = row & 63;
#pragma unroll
            for (int j = 0; j < 4; ++j) { const int ch = 4 * lane + 256 * j; const f32x4 pe = (j < 2) ? *(const f32x4*)(posr + pr * 512 + ch) : *(const f32x4*)(posc + pc * 512 + ch - 512);
                v[j] = *(const f32x4*)(P.x + (size_t)row * D + ch) + pe; }
        }
        float* xo = isc ? XC + (size_t)(row - SEQ) * D : P.out + (size_t)row * D;
        float ss = 0.f;
#pragma unroll
        for (int j = 0; j < 4; ++j) { *(f32x4*)(xo + 4 * lane + 256 * j) = v[j]; ss += (v[j][0] * v[j][0] + v[j][1] * v[j][1]) + (v[j][2] * v[j][2] + v[j][3] * v[j][3]); }
        ss = wave_sum(ss); if (lane == 0) SS[row] = ss;
#pragma unroll
        for (int j = 0; j < 4; ++j) { const int ch = 4 * lane + 256 * j; const f32x4 sc = *(const f32x4*)(mv + D + ch);
            const f32x4 y = v[j] * gn[j] * (sc + 1.0f);
            v2u w; w.x = cvt_pk_bf16(y[0], y[1]); w.y = cvt_pk_bf16(y[2], y[3]);
            *(v2u*)(Hout + (size_t)row * D + ch) = w; }
    }
    for (int it = C.bid * NT + C.tid; it < 2 * 2 * 2 * D; it += C.G * NT) { const int k = it & (D - 1), nrm = (it >> 10) & 1, wh = (it >> 11) & 1, l = it >> 12;
        const float g = (nrm ? P.norm2_g : P.norm1_g)[l * D + k]; ((float*)(C.ws + WS_GV))[it] = g * (1.0f + modl[(size_t)(l * 2 + wh) * NMOD + (nrm ? 4 * D : D) + k]); }
}

__device__ __forceinline__ void phase_setup(const Ctx& C0) {
    const Ctx C = mkctx(C0.lds, C0.ws, C0.wv); const Params P = load_params(); (void)P;
    float* red = (float*)C.lds;
    for (int b = C.bid; b < 192; b += C.G) {
        const int l = b / 96, n0 = (b % 96) * 64, k0 = C.wave * 128;
        const float* W = P.w_mod + (size_t)l * D * NMOD + n0 + C.lane;
        float a0 = 0.f, a1 = 0.f;
#pragma unroll 32
        for (int k = 0; k < 128; ++k) { const float w = W[(size_t)(k0 + k) * NMOD]; a0 = fmaf(silu_f(P.c[k0 + k]), w, a0); a1 = fmaf(silu_f(P.c_ctx[k0 + k]), w, a1); }
        red[(C.wave * 2 + 0) * 64 + C.lane] = a0; red[(C.wave * 2 + 1) * 64 + C.lane] = a1;
        __syncthreads();
        if (C.wave < 2) { float s = 0.f;
#pragma unroll
            for (int w = 0; w < 8; ++w) s += red[(w * 2 + C.wave) * 64 + C.lane];
            ((float*)(C.ws + WS_MOD))[(size_t)(l * 2 + C.wave) * NMOD + n0 + C.lane] = s + P.b_mod[(size_t)l * NMOD + n0 + C.lane]; }
        __syncthreads();
    }
    const int gt = C.bid * NT + C.tid, NGT = C.G * NT;
    for (int it = gt; it < 4 * MR; it += NGT) ((float*)(C.ws + WS_SS))[it] = 0.f;
    for (int it = gt; it < 4 * NCV; it += NGT) ((float*)(C.ws + WS_CV))[it] = 0.f;
    for (int it = gt; it < 8192; it += NGT) {
        const float lr = P.lam_re[it], li = P.lam_im[it], dt = expf(P.log_step[it >> 6]);
        const float mag = expf(lr * dt); float sn, cs; sincos_cw(li * dt, sn, cs);
        const float ar = mag * cs, ai = mag * sn, nr = ar - 1.0f, ni = ai, den = lr * lr + li * li;
        const float fr_ = (nr * lr + ni * li) / den, fi_ = (ni * lr - nr * li) / den;
        float* ap = (float*)(C.ws + WS_APOW) + (size_t)it * 34; float pr = 1.f, pi = 0.f;
        for (int t = 0; t <= 16; ++t) { ap[2 * t] = pr; ap[2 * t + 1] = pi; const float qr = pr * ar - pi * ai, qi = pr * ai + pi * ar; if (t == 16) { ((float*)(C.ws + WS_A16))[2 * it] = pr; ((float*)(C.ws + WS_A16))[2 * it + 1] = pi; } pr = qr; pi = qi; }
        float* bt = (float*)(C.ws + WS_BTC) + (size_t)it * 32;
        for (int c = 0; c < 16; ++c) { const float br = P.b_re[(size_t)it * 16 + c], bi = P.b_im[(size_t)it * 16 + c]; bt[2 * c] = fr_ * br - fi_ * bi; bt[2 * c + 1] = fr_ * bi + fi_ * br; }
    }
    for (int it = gt; it < 320 * 256; it += NGT) {
        const int r = it >> 8, i = it & 255; const float om = 1.0f / powf(10000.0f, (float)i * (1.0f / 256.0f));
        const float pv = (float)(r < 256 ? r : r - 256); float sn, cs; sincos_cw(pv * om, sn, cs);
        float* T = (r < 256) ? (float*)(C.ws + WS_POSR) + (size_t)r * 512 : (float*)(C.ws + WS_POSC) + (size_t)(r - 256) * 512;
        T[i] = sn; T[256 + i] = cs;
    }
}

__device__ __forceinline__ void build_s5_mats(const Ctx& C0, int l, int sb, int sG) {
    const Ctx C = mkctx(C0.lds, C0.ws, C0.wv); const Params P = load_params(); (void)P;
    const int gt = sb * NT + C.tid, NGT = sG * NT;
    const float* apow = (const float*)(C.ws + WS_APOW) + (size_t)l * 4096 * 34;
    const float* btc = (const float*)(C.ws + WS_BTC) + (size_t)l * 4096 * 32;
    const float* cre = P.c_re + (size_t)l * 2 * NG * 16 * NP; const float* cim = P.c_im + (size_t)l * 2 * NG * 16 * NP;
    bf16* BAM = (bf16*)(C.ws + (l ? WS_BAM1 : WS_BAM)); bf16* TC = (bf16*)(C.ws + (l ? WS_TC1 : WS_TC));
    for (int it = gt; it < NG * 16 * 256; it += NGT) {
        const int cp = it & 15, c = (it >> 4) & 15, tau = (it >> 8) & 15, g = it >> 12;
        float kk[2];
#pragma unroll
        for (int d = 0; d < 2; ++d) { float s = 0.f; const float* cr = cre + ((size_t)(d * NG + g) * 16 + c) * NP; const float* ci = cim + ((size_t)(d * NG + g) * 16 + c) * NP;
            const float* ap = apow + (size_t)(d * NG + g) * NP * 34 + 2 * tau; const float* bt = btc + (size_t)(d * NG + g) * NP * 32 + 2 * cp;
#pragma unroll 16
            for (int p = 0; p < NP; ++p) { const float pr = ap[p * 34], pi = ap[p * 34 + 1], br = bt[p * 32], bi = bt[p * 32 + 1];
                const float zr = pr * br - pi * bi, zi = pr * bi + pi * br; s += cr[p] * zr - ci[p] * zi; }
            kk[d] = s; }
        bf16* T = TC + (size_t)g * 256 * 512;
        if (tau == 0) { const bf16 v = (bf16)f2bf(kk[0] + kk[1] + (c == cp ? P.ssm_d[(size_t)l * SSMW + g * 16 + c] : 0.f)); for (int t = 0; t < 16; ++t) T[(size_t)(t * 16 + c) * 512 + t * 16 + cp] = v; }
        else { const bf16 vf = (bf16)f2bf(kk[0]), vr = (bf16)f2bf(kk[1]);
            for (int t = tau; t < 16; ++t) { T[(size_t)(t * 16 + c) * 512 + (t - tau) * 16 + cp] = vf; T[(size_t)((t - tau) * 16 + c) * 512 + t * 16 + cp] = vr; } }
    }
    for (int it = gt; it < NG * 256 * 128; it += NGT) {
        const int p = it & 63, d = (it >> 6) & 1, c = (it >> 7) & 15, t = (it >> 11) & 15, g = it >> 15;
        const int e = d ? 16 - t : t + 1; const size_t ci_ = ((size_t)(d * NG + g) * 16 + c) * NP + p;
        const float cr = cre[ci_], ci = cim[ci_]; const float* ap = apow + ((size_t)(d * NG + g) * NP + p) * 34 + 2 * e;
        const float wr_ = cr * ap[0] - ci * ap[1], wi_ = cr * ap[1] + ci * ap[0];
        bf16* T = TC + ((size_t)g * 256 + t * 16 + c) * 512 + 256 + d * 128 + p;
        T[0] = (bf16)f2bf(wr_); T[64] = (bf16)f2bf(-wi_);
    }
    for (int it = gt; it < NG * 2 * NP * 256; it += NGT) {
        const int cp = it & 15, j = (it >> 4) & 15, p = (it >> 8) & 63, d = (it >> 14) & 1, g = it >> 15;
        const int e = d ? j : 15 - j; const float* ap = apow + ((size_t)(d * NG + g) * NP + p) * 34 + 2 * e; const float* bt = btc + ((size_t)(d * NG + g) * NP + p) * 32 + 2 * cp;
        const float vr = ap[0] * bt[0] - ap[1] * bt[1], vi = ap[0] * bt[1] + ap[1] * bt[0];
        bf16* B = BAM + ((size_t)g * 256 + d * 128 + p) * 256 + j * 16 + cp;
        B[0] = (bf16)f2bf(vr); B[(size_t)64 * 256] = (bf16)f2bf(vi);
    }
}

#define GAS __attribute__((address_space(1)))
template <int DIR, int N>
__device__ __forceinline__ void run_load(__amdgpu_buffer_rsrc_t RS, unsigned vs, float (&sr)[N], float (&si)[N]) {
    constexpr int STS = (DIR ? -8192 : 8192) * 4;
    const int bs = (int)(vs * 4u) + (DIR ? (N - 1) * STS : 0);
#pragma unroll
    for (int k = 0; k < N; ++k) { const int so = DIR ? (N - 1 - k) * (-STS) : k * STS; sr[k] = __builtin_bit_cast(float, __builtin_amdgcn_raw_buffer_load_b32(RS, bs, so, 0)); si[k] = __builtin_bit_cast(float, __builtin_amdgcn_raw_buffer_load_b32(RS, bs + 256, so, 0)); }
}
template <int DIR, int N, bool WRITE>
__device__ __forceinline__ void run_scan(__amdgpu_buffer_rsrc_t RH, unsigned vre, unsigned vim, const float (&sr)[N], const float (&si)[N], float ar, float ai, float& hr, float& hi) {
    constexpr int STH = (DIR ? -8192 : 8192) * 2;
    const int bre = (int)(vre * 2u) + (DIR ? (N - 1) * STH : 0), bim = (int)(vim * 2u) + (DIR ? (N - 1) * STH : 0);
#pragma unroll
    for (int k = 0; k < N; ++k) {
        if (WRITE) { const int so = DIR ? (N - 1 - k) * (-STH) : k * STH; __builtin_amdgcn_raw_buffer_store_b16((short)f2bf(hr), RH, bre, so, 0); __builtin_amdgcn_raw_buffer_store_b16((short)f2bf(hi), RH, bim, so, 0); }
        const float nr = ar * hr - ai * hi + sr[k], ni = ar * hi + ai * hr + si[k]; hr = nr; hi = ni; }
}
template <int DIR>
__device__ __forceinline__ void carry_scan_d(const Ctx& C, int l, int g) {
    constexpr int d = DIR; const int p = C.lane, w = C.wave;
    const __amdgpu_buffer_rsrc_t S = __builtin_amdgcn_make_buffer_rsrc((void*)(C.ws + WS_XR), 0, 0x7ffffffe, 0x00020000);
    const __amdgpu_buffer_rsrc_t H = __builtin_amdgcn_make_buffer_rsrc((void*)(C.ws + WS_HST), 0, 0x7ffffffe, 0x00020000);
    const float* a16p = (const float*)(C.ws + WS_A16) + 2 * ((size_t)((l * 2 + d) * NG + g) * NP + p);
    const float ar = a16p[0], ai = a16p[1];
    const int nre = d * 128 + p, nim = nre + 64;
    const unsigned ls = (unsigned)(g * 256 + d * 128 + p), lre = (unsigned)((nre >> 4) * 512 + g * 16 + (nre & 15)), lim = (unsigned)((nim >> 4) * 512 + g * 16 + (nim & 15));
    const int cc0 = DIR ? NCH - 1 : SEQ / 16;
    const int lc0 = DIR ? (SEQ / 16 - 1 - 128 * w) : 128 * w;
    constexpr int QS = DIR ? -32 : 32;
    const unsigned c0 = (unsigned)lc0 * 8192u, c1 = (unsigned)(lc0 + QS) * 8192u, c2 = (unsigned)(lc0 + 2 * QS) * 8192u, c3 = (unsigned)(lc0 + 3 * QS) * 8192u, cc = (unsigned)cc0 * 8192u;
    float* ends = (float*)C.lds;
    float er = 0.f, ei = 0.f, hr = 0.f, hi = 0.f;
    float q3r[32], q3i[32];
    {   float xr[16], xi[16], ar0[32], ai0[32], ar1[32], ai1[32];
        run_load<DIR, 16>(S, cc + ls, xr, xi); run_load<DIR, 32>(S, c0 + ls, ar0, ai0); run_load<DIR, 32>(S, c1 + ls, ar1, ai1);
        if (w == 0) run_scan<DIR, 16, true>(H, cc + lre, cc + lim, xr, xi, ar, ai, er, ei); else run_scan<DIR, 16, false>(H, 0u, 0u, xr, xi, ar, ai, er, ei);
        run_scan<DIR, 32, false>(H, 0u, 0u, ar0, ai0, ar, ai, hr, hi); run_scan<DIR, 32, false>(H, 0u, 0u, ar1, ai1, ar, ai, hr, hi); }
    {   float br[32], bi[32];
        run_load<DIR, 32>(S, c2 + ls, br, bi); run_load<DIR, 32>(S, c3 + ls, q3r, q3i);
        run_scan<DIR, 32, false>(H, 0u, 0u, br, bi, ar, ai, hr, hi); run_scan<DIR, 32, false>(H, 0u, 0u, q3r, q3i, ar, ai, hr, hi); }
    ends[(w * 64 + p) * 2] = hr; ends[(w * 64 + p) * 2 + 1] = hi;
    float pr = ar, pi = ai;
#pragma unroll
    for (int i = 0; i < 7; ++i) { const float qr = pr * pr - pi * pi, qi = 2.f * pr * pi; pr = qr; pi = qi; }
    float ar0[32], ai0[32], ar1[32], ai1[32];
    run_load<DIR, 32>(S, c0 + ls, ar0, ai0); run_load<DIR, 32>(S, c1 + ls, ar1, ai1);
    __syncthreads();
    hr = er; hi = ei;
    for (int ww = 0; ww < w; ++ww) { const float xr = ends[(ww * 64 + p) * 2], xi = ends[(ww * 64 + p) * 2 + 1]; const float nr = pr * hr - pi * hi + xr, ni = pr * hi + pi * hr + xi; hr = nr; hi = ni; }
    run_scan<DIR, 32, true>(H, c0 + lre, c0 + lim, ar0, ai0, ar, ai, hr, hi);
    { float br[32], bi[32]; run_load<DIR, 32>(S, c2 + ls, br, bi);
      run_scan<DIR, 32, true>(H, c1 + lre, c1 + lim, ar1, ai1, ar, ai, hr, hi);
      run_scan<DIR, 32, true>(H, c2 + lre, c2 + lim, br, bi, ar, ai, hr, hi); }
    run_scan<DIR, 32, true>(H, c3 + lre, c3 + lim, q3r, q3i, ar, ai, hr, hi);
    __syncthreads();
}
__device__ __forceinline__ void carry_scan(const Ctx& C0, int l, int gd) {
    const Ctx C = mkctx(C0.lds, C0.ws, C0.wv);
    if (gd & 1) carry_scan_d<1>(C, l, gd >> 1); else carry_scan_d<0>(C, l, gd >> 1);
}

template <int RR> struct ConvStep {
    static __device__ __forceinline__ void run(f32x2 (&acc)[32], const f32x2 (&wk)[31], const bf16* VB, int r0, int len) {
        ConvStep<RR - 1>::run(acc, wk, VB, r0, len);
        const int ir = r0 - 15 + RR, irc = ir < 0 ? 0 : (ir >= len ? len - 1 : ir);
        unsigned raw = *(const unsigned*)(VB + (size_t)irc * D); raw = (ir == irc) ? raw : 0u;
        const f32x2 v = (f32x2){bf_lo(raw), bf_hi(raw)};
        constexpr int J0 = RR - 30 > 0 ? RR - 30 : 0, J1 = RR < 31 ? RR : 31;
#pragma unroll
        for (int j = J0; j <= J1; ++j) acc[j] += v * wk[RR - j];
    }
};
template <> struct ConvStep<-1> { static __device__ __forceinline__ void run(f32x2 (&)[32], const f32x2 (&)[31], const bf16*, int, int) {} };
__device__ __forceinline__ void conv_tile(const Ctx& C0, int l, int tile) {
    const Ctx C = mkctx(C0.lds, C0.ws, C0.wv); const Params P = load_params();
    const int tid = C.tid; const bool isc = tile >= SEQ / 32; const int base = isc ? SEQ : 0, len = isc ? CTXN : SEQ, r0 = (isc ? tile - SEQ / 32 : tile) * 32;
    const bf16* VB = (const bf16*)(C.ws + WS_VB) + (size_t)base * D + 2 * tid;
    const float* dw = P.dw_kernel + (size_t)l * 31 * D + 2 * tid;
    f32x2 wk[31];
#pragma unroll
    for (int k = 0; k < 31; ++k) wk[k] = *(const f32x2*)(dw + (size_t)k * D);
    const f32x2 bias = *(const f32x2*)(P.dw_bias + (size_t)l * D + 2 * tid);
    f32x2 acc[32];
#pragma unroll
    for (int j = 0; j < 32; ++j) acc[j] = bias;
    ConvStep<61>::run(acc, wk, VB, r0, len);
    float* tl = (float*)C.lds;
#pragma unroll
    for (int j = 0; j < 32; ++j) *(f32x2*)(tl + j * D + 2 * tid) = acc[j];
    __syncthreads();
    bf16* A2 = (bf16*)(C.ws + WS_A2);
    const float* cg = P.cn_g + (size_t)l * D; const float* cb = P.cn_b + (size_t)l * D;
#pragma unroll
    for (int jj = 0; jj < 4; ++jj) { const int j = C.wave * 4 + jj; f32x4 v[4]; float s = 0.f;
#pragma unroll
        for (int q = 0; q < 4; ++q) { v[q] = *(const f32x4*)(tl + j * D + 4 * C.lane + 256 * q); s += (v[q][0] + v[q][1]) + (v[q][2] + v[q][3]); }
        const float mu = wave_sum(s) * (1.0f / D); float s2 = 0.f;
#pragma unroll
        for (int q = 0; q < 4; ++q) { v[q] = v[q] - mu; s2 += (v[q][0] * v[q][0] + v[q][1] * v[q][1]) + (v[q][2] * v[q][2] + v[q][3] * v[q][3]); }
        const float rstd = rsqrtf(wave_sum(s2) * (1.0f / D) + EPS);
#pragma unroll
        for (int q = 0; q < 4; ++q) { const int ch = 4 * C.lane + 256 * q; const f32x4 y = v[q] * rstd * *(const f32x4*)(cg + ch) + *(const f32x4*)(cb + ch);
            v2u w; w.x = cvt_pk_bf16(silu_f(y[0]), silu_f(y[1])); w.y = cvt_pk_bf16(silu_f(y[2]), silu_f(y[3]));
            *(v2u*)(A2 + (size_t)(base + r0 + j) * 1536 + 512 + ch) = w; } }
    __syncthreads();
}

__device__ __forceinline__ void rows_final(const Ctx& C0) {
    const Ctx C = mkctx(C0.lds, C0.ws, C0.wv); const Params P = load_params(); (void)P;
    const int gw = C.bid * NWAVES + C.wave, NGW = C.G * NWAVES, lane = C.lane;
    f32x4 gn[4];
#pragma unroll
    for (int j = 0; j < 4; ++j) gn[j] = *(const f32x4*)(P.norm_f_g + 4 * lane + 256 * j);
    for (int row = gw; row < SEQ; row += NGW) { float* xr = P.out + (size_t)row * D; f32x4 v[4]; float ss = 0.f;
#pragma unroll
        for (int j = 0; j < 4; ++j) { v[j] = *(const f32x4*)(xr + 4 * lane + 256 * j); ss += (v[j][0] * v[j][0] + v[j][1] * v[j][1]) + (v[j][2] * v[j][2] + v[j][3] * v[j][3]); }
        const float rstd = rsqrtf(wave_sum(ss) * (1.0f / D) + EPS);
#pragma unroll
        for (int j = 0; j < 4; ++j) *(f32x4*)(xr + 4 * lane + 256 * j) = v[j] * rstd * gn[j]; }
}


template <int K, int LDA, int MODE>
__device__ __forceinline__ void ctx_gemm(int wv, unsigned char* lds, const bf16* A, const bf16* Bt, const bf16* SA, const bf16* SB, bf16* MG, float* XC, const float* gate, const float* gv, bf16* XGo, float* SSo) {
    int t_ = tid_of(wv); asm volatile("" : "+v"(t_));
    const int lane = t_ & 63, wave = wv, r = lane & 15, q = lane >> 4, half = wave >> 2, w4 = wave & 3;
    constexpr int K0 = (MODE == 0) ? 512 : K / 2;
    pg8::f32x4* xch = (pg8::f32x4*)lds;
    for (int t0 = blockIdx.x * 4; t0 < 16 * 64; t0 += gridDim.x * 4) {
        const int task = t0 + w4, ni = task >> 4, mi = task & 15;
        const bf16* ap = A + (size_t)(mi * 16 + r) * LDA + 8 * q; const bf16* bp = Bt + (size_t)(ni * 16 + r) * K + 8 * q;
        pg8::f32x4 acc = {0.f, 0.f, 0.f, 0.f};
        constexpr int NS0 = K0 / 32, NS1 = (K - K0) / 32;
        if (!half) {
#pragma unroll 16
            for (int i = 0; i < NS0; ++i) { const pg8::bf16x8 a = *(const pg8::bf16x8*)(ap + 32 * i), b = *(const pg8::bf16x8*)(bp + 32 * i); acc = __builtin_amdgcn_mfma_f32_16x16x32_bf16(b, a, acc, 0, 0, 0); }
        } else {
#pragma unroll 16
            for (int i = 0; i < NS1; ++i) { const pg8::bf16x8 a = *(const pg8::bf16x8*)(ap + K0 + 32 * i), b = *(const pg8::bf16x8*)(bp + K0 + 32 * i); acc = __builtin_amdgcn_mfma_f32_16x16x32_bf16(b, a, acc, 0, 0, 0); }
        }
        if (half) xch[w4 * 64 + lane] = acc;
        __syncthreads();
        if (!half) {
            const pg8::f32x4 acc2 = xch[w4 * 64 + lane];
            const int row = mi * 16 + r, col = ni * 16 + 4 * q;
            if (MODE == 0) { const size_t off = (size_t)(SEQ + row) * D + col; const v2u a = *(const v2u*)(SA + off), b = *(const v2u*)(SB + off);
                v2u w; w.x = cvt_pk_bf16(bf_lo(a.x) * acc[0] + bf_lo(b.x) * acc2[0], bf_hi(a.x) * acc[1] + bf_hi(b.x) * acc2[1]);
                w.y = cvt_pk_bf16(bf_lo(a.y) * acc[2] + bf_lo(b.y) * acc2[2], bf_hi(a.y) * acc[3] + bf_hi(b.y) * acc2[3]);
                *(v2u*)(MG + off) = w; }
            else { f32x4* p = (f32x4*)(XC + (size_t)row * D + col); const f32x4 g = *(const f32x4*)(gate + col); f32x4 a4 = {acc[0] + acc2[0], acc[1] + acc2[1], acc[2] + acc2[2], acc[3] + acc2[3]}; const f32x4 xv = *p + g * a4; *p = xv;
                const f32x4 y = xv * *(const f32x4*)(gv + col); v2u w; w.x = cvt_pk_bf16(y[0], y[1]); w.y = cvt_pk_bf16(y[2], y[3]); *(v2u*)(XGo + (size_t)(SEQ + row) * D + col) = w;
                float ss = (xv[0] * xv[0] + xv[1] * xv[1]) + (xv[2] * xv[2] + xv[3] * xv[3]); ss += __shfl_xor(ss, 16); ss += __shfl_xor(ss, 32); if (q == 0) atomicAdd(SSo + SEQ + row, ss); }
        }
        __syncthreads();
    }
}

__device__ __forceinline__ void mixer_prep(unsigned char* lds, int wv, int l, int sb, int sG) {
    const Params P = load_params(); unsigned char* ws = P.ws; const Ctx C1 = mkctx(lds, ws, wv); float* scr = (float*)(lds + C1.wave * 16384);
    const float* sh = (const float*)(ws + WS_MOD) + (size_t)l * 2 * NMOD;
    float* cvo = (float*)(ws + WS_CV) + (size_t)l * 2 * NCV;
    for (int it0 = sb * NWAVES + C1.wave; ; it0 += sG * NWAVES) { int it = it0;
        if (transpose_job(it, P.w_in + (size_t)l * D * WIN, D, WIN, (bf16*)(ws + WS_WIN), D, 0, 1, scr, C1.lane, sh, cvo)) continue;
        if (transpose_job(it, P.w_glu + (size_t)l * SSMW * SSMW, SSMW, SSMW, (bf16*)(ws + WS_WGLU), SSMW, 0, 0, scr, C1.lane)) continue;
        if (transpose_job(it, P.w_proj_a + (size_t)l * SSMW * D, SSMW, D, (bf16*)(ws + WS_WPROJ), 1536, 0, 0, scr, C1.lane)) continue;
        if (transpose_job(it, P.w_proj_b + (size_t)l * D * D, D, D, (bf16*)(ws + WS_WPROJ), 1536, 512, 0, scr, C1.lane)) continue;
        if (transpose_job(it, P.w_out + (size_t)l * D * D, D, D, (bf16*)(ws + WS_WOUT), D, 0, 0, scr, C1.lane)) continue;
        break; }
}
__device__ __forceinline__ void ffn_prep(unsigned char* lds, int wv, int l, int sb, int sG) {
    const Params P = load_params(); unsigned char* ws = P.ws; const Ctx C1 = mkctx(lds, ws, wv); float* scr = (float*)(lds + C1.wave * 16384);
    const float* sh = (const float*)(ws + WS_MOD) + (size_t)l * 2 * NMOD + 3 * D;
    float* cvo = (float*)(ws + WS_CV) + (size_t)l * 2 * NCV + WIN;
    for (int it0 = sb * NWAVES + C1.wave; ; it0 += sG * NWAVES) { int it = it0;
        if (transpose_job(it, P.w_gate + (size_t)l * D * FF, D, FF, (bf16*)(ws + WS_WGU), D, 0, 2, scr, C1.lane, sh, cvo)) continue;
        if (transpose_job(it, P.w_up + (size_t)l * D * FF, D, FF, (bf16*)(ws + WS_WGU), D, 0, 3, scr, C1.lane, sh, cvo)) continue;
        if (transpose_job(it, P.w_down + (size_t)l * FF * D, FF, D, (bf16*)(ws + WS_WD), FF, 0, 0, scr, C1.lane)) continue;
        break; }
}

__device__ __forceinline__ void conv_grab(const Ctx& C0, int l, int maxn) {
    unsigned* cnt = (unsigned*)(C0.ws + WS_CTL) + 8192 + 64 * l;
    volatile LAS unsigned* slot = (volatile LAS unsigned*)((LAS unsigned char*)C0.lds + MISC_OFF) + 16;
    for (int n = 0; n < maxn; ++n) {
        if (tid_of(C0.wv) == 0) slot[0] = atomicAdd(cnt, 1u);
        __syncthreads();
        const int tile = (int)slot[0];
        __syncthreads();
        if (tile >= MR / 32) break;
        conv_tile(C0, l, tile);
    }
}

#define GRID_BAR() xcd_barrier(bar)
template <int L>
__device__ __forceinline__ void layer_body(const Ctx& C, unsigned char* lds, PG8_LAS unsigned char* ldsl, int wv, const XcdBarrier& bar) {
        constexpr int l = L; constexpr bool last = (L == 1);
        constexpr int mr = last ? SEQ : MR;
        { unsigned char* ws = load_params().ws; typedef pg8::Cfg<D, D, 16, 1 << 30, -1, 0> CF; pg8::Gemm g{(const bf16*)(ws + WS_XR), (const bf16*)(ws + WS_XR), (const bf16*)(ws + WS_WIN)};
          pg8::StaticOrder S; S.init(MR, WIN, C.G, C.bid);
          EpiWin E{(bf16*)(ws + WS_U), (bf16*)(ws + WS_VB), (bf16*)(ws + WS_SA), (bf16*)(ws + WS_SB), (const float*)(ws + WS_SS) + (size_t)(l * 2) * MR, (const float*)(ws + WS_CV) + (size_t)l * 2 * NCV};
          pg8::gemm_phase<CF>(ldsl, g, S, E, wv); }
        GRID_BAR();
        { unsigned char* ws = load_params().ws; typedef pg8::Cfg<256, 16 * SSMW, SSMW, 1 << 30, -1, 16> CF; pg8::Gemm g{(const bf16*)(ws + WS_U), (const bf16*)(ws + WS_U), (const bf16*)(ws + (l ? WS_BAM1 : WS_BAM))};
          pg8::StaticOrder S; S.init(NCHP, NG * 256, C.G, C.bid);
          EpiS1 E{(float*)(ws + WS_XR)};
          pg8::gemm_phase<CF>(ldsl, g, S, E, wv);
          if (C.bid >= (NCHP / 256) * NG) conv_grab(C, l, 1); }
        GRID_BAR();
        { if (C.G > 64) { if (C.bid < 64) carry_scan(C, l, C.bid); else conv_grab(C, l, 2); }
          else { for (int gd = C.bid; gd < 64; gd += C.G) carry_scan(C, l, gd); conv_grab(C, l, 2); } }
        GRID_BAR();
        { unsigned char* ws = load_params().ws; typedef pg8::Cfg<512, 16 * SSMW, SSMW, 4, -1, 16> CF; pg8::Gemm g{(const bf16*)(ws + WS_U), (const bf16*)(ws + WS_HST), (const bf16*)(ws + (l ? WS_TC1 : WS_TC))};
          pg8::StaticOrder S; S.init(NCHP, NG * 256, C.G, C.bid);
          EpiS3 E{(bf16*)(ws + WS_XR)};
          pg8::gemm_phase<CF>(ldsl, g, S, E, wv);
          if (C.bid >= (NCHP / 256) * NG) conv_grab(C, l, 1 << 20); else if (C.G <= (NCHP / 256) * NG) conv_grab(C, l, 1 << 20); }
        GRID_BAR();
        { unsigned char* ws = load_params().ws; typedef pg8::Cfg<SSMW, SSMW, 16, 1 << 30, -1, 0> CF; pg8::Gemm g{(const bf16*)(ws + WS_XR), (const bf16*)(ws + WS_XR), (const bf16*)(ws + WS_WGLU)};
          pg8::StaticOrder S; S.init(mr, SSMW, C.G, C.bid);
          EpiGlu E{(const bf16*)(ws + WS_XR), (bf16*)(ws + WS_A2)};
          pg8::gemm_phase<CF>(ldsl, g, S, E, wv);
          const int nu = (mr / 256) * 2;
          if (C.G > nu) { if (C.bid >= nu) ffn_prep(lds, wv, l, C.bid - nu, C.G - nu); } else ffn_prep(lds, wv, l, C.bid, C.G); }
        GRID_BAR();
        { unsigned char* ws = load_params().ws; typedef pg8::Cfg<1536, 1536, 16, 1 << 30, 8, 0> CF; pg8::Gemm g{(const bf16*)(ws + WS_A2), (const bf16*)(ws + WS_A2), (const bf16*)(ws + WS_WPROJ)};
          pg8::StaticOrder S; S.init(SEQ, D, C.G, C.bid);
          EpiMerged E{(const bf16*)(ws + WS_SA), (const bf16*)(ws + WS_SB), (bf16*)(ws + WS_VB)};
          pg8::gemm_phase<CF>(ldsl, g, S, E, wv);
          if constexpr (!last) ctx_gemm<1536, 1536, 0>(wv, lds, (const bf16*)(ws + WS_A2) + (size_t)SEQ * 1536, (const bf16*)(ws + WS_WPROJ), (const bf16*)(ws + WS_SA), (const bf16*)(ws + WS_SB), (bf16*)(ws + WS_VB), nullptr, nullptr, nullptr, nullptr, nullptr); }
        GRID_BAR();
        { unsigned char* ws = load_params().ws; typedef pg8::Cfg<D, D, 16, 1 << 30, -1, 0> CF; pg8::Gemm g{(const bf16*)(ws + WS_VB), (const bf16*)(ws + WS_VB), (const bf16*)(ws + WS_WOUT)};
          pg8::StaticOrder S; S.init(SEQ, D, C.G, C.bid);
          const float* modl = (const float*)(ws + WS_MOD) + (size_t)l * 2 * NMOD; const float* gvl = (const float*)(ws + WS_GV) + (size_t)(l * 4 + 1) * D;
          float* ss2 = (float*)(ws + WS_SS) + (size_t)(l * 2 + 1) * MR;
          { EpiRes<true> E{load_params().out, modl + 2 * D, gvl, (bf16*)(ws + WS_XR), ss2, nullptr, nullptr, nullptr}; pg8::gemm_phase<CF>(ldsl, g, S, E, wv); }
          if constexpr (!last) ctx_gemm<D, D, 1>(wv, lds, (const bf16*)(ws + WS_VB) + (size_t)SEQ * D, (const bf16*)(ws + WS_WOUT), nullptr, nullptr, nullptr, (float*)(ws + WS_XC), modl + NMOD + 2 * D, gvl + 2 * D, (bf16*)(ws + WS_XR), ss2); }
        GRID_BAR();
        { unsigned char* ws = load_params().ws; typedef pg8::Cfg<D, D, 16, 1 << 30, -1, 0> CF; pg8::Gemm g{(const bf16*)(ws + WS_XR), (const bf16*)(ws + WS_XR), (const bf16*)(ws + WS_WGU)};
          pg8::StaticOrder S; S.init(mr, 2 * FF, C.G, C.bid);
          EpiFfn E{(bf16*)(ws + WS_HID), (const float*)(ws + WS_SS) + (size_t)(l * 2 + 1) * MR, (const float*)(ws + WS_CV) + (size_t)l * 2 * NCV + WIN};
          pg8::gemm_phase<CF>(ldsl, g, S, E, wv);
          if constexpr (!last) { const int nfull = ((mr / 256) * 22) % C.G;
              if (nfull) { if (C.bid >= nfull) mixer_prep(lds, wv, 1, C.bid - nfull, C.G - nfull); }
              else mixer_prep(lds, wv, 1, C.bid, C.G); } }
        GRID_BAR();
        { unsigned char* ws = load_params().ws; typedef pg8::Cfg<FF, FF, 16, 1 << 30, -1, 0> CF; pg8::Gemm g{(const bf16*)(ws + WS_HID), (const bf16*)(ws + WS_HID), (const bf16*)(ws + WS_WD)};
          pg8::StaticOrder S; S.init(SEQ, D, C.G, C.bid);
          const float* modl = (const float*)(ws + WS_MOD) + (size_t)l * 2 * NMOD;
          if constexpr (last) { EpiRes<false> E{load_params().out, modl + 5 * D, nullptr, nullptr, nullptr, nullptr, nullptr, nullptr}; pg8::gemm_phase<CF>(ldsl, g, S, E, wv); }
          else { const float* gvn = (const float*)(ws + WS_GV) + (size_t)(4 + 0) * D;
              float* ss1 = (float*)(ws + WS_SS) + (size_t)2 * MR;
              EpiRes<true> E{load_params().out, modl + 5 * D, gvn, (bf16*)(ws + WS_XR), ss1, nullptr, nullptr, nullptr};
              pg8::gemm_phase<CF>(ldsl, g, S, E, wv);
              ctx_gemm<FF, FF, 1>(wv, lds, (const bf16*)(ws + WS_HID) + (size_t)SEQ * FF, (const bf16*)(ws + WS_WD), nullptr, nullptr, nullptr, (float*)(ws + WS_XC), modl + NMOD + 5 * D, gvn + 2 * D, (bf16*)(ws + WS_XR), ss1); } }
        GRID_BAR();
}

__global__ void __launch_bounds__(NT, 2) fwd_megakernel(Params Pk) {
    extern __shared__ __attribute__((aligned(16))) unsigned char lds[];
    const int wv = __builtin_amdgcn_readfirstlane((int)threadIdx.x >> 6);
    Ctx C; C.tid = tid_of(wv); C.lane = C.tid & 63; C.wave = wv; C.wv = wv; C.G = gridDim.x; C.bid = blockIdx.x; C.lds = lds; C.ws = Pk.ws;
    PG8_LAS unsigned char* ldsl = (PG8_LAS unsigned char*)lds;
    volatile LAS unsigned* MISC = (volatile LAS unsigned*)(ldsl + MISC_OFF);
    for (int u = C.tid; u < (LDS_BYTES - 131072) / 4; u += NT) ((LAS unsigned*)(ldsl + 131072))[u] = 0u;
    __syncthreads();
    XcdBarrier bar = xcd_barrier_post((unsigned*)(Pk.ws + WS_CTL), MISC + 8, wv);

    phase_setup(C);
    GRID_BAR();
    rows_first(C);
    mixer_prep(lds, wv, 0, C.bid, C.G);
    build_s5_mats(C, 0, C.bid, C.G);
    build_s5_mats(C, 1, C.bid, C.G);
    GRID_BAR();

    layer_body<0>(C, lds, ldsl, wv, bar);
    layer_body<1>(C, lds, ldsl, wv, bar);
    rows_final(C);
}

extern "C" void kernel_launch(void* const* d_in, const int* in_sizes, int n_in, void* d_out, int out_size, void* d_ws, size_t ws_size, hipStream_t stream) {
    static int grid = 0;
    if (grid == 0) {
        if (n_in != 29 || out_size != SEQ * D || ws_size < WS_END) { fprintf(stderr, "kernel_launch: unexpected shapes (n_in %d out %d ws %zu)\n", n_in, out_size, ws_size); grid = -1; return; }
        int dev = 0, cus = 0, per_cu = 0;
        if (hipGetDevice(&dev) != hipSuccess || hipDeviceGetAttribute(&cus, hipDeviceAttributeMultiprocessorCount, dev) != hipSuccess) { grid = -1; return; }
        if (hipFuncSetAttribute((const void*)fwd_megakernel, hipFuncAttributeMaxDynamicSharedMemorySize, LDS_BYTES) != hipSuccess) { fprintf(stderr, "kernel_launch: hipFuncSetAttribute failed\n"); grid = -1; return; }
        if (hipOccupancyMaxActiveBlocksPerMultiprocessor(&per_cu, (const void*)fwd_megakernel, NT, LDS_BYTES) != hipSuccess || per_cu < 1) { fprintf(stderr, "kernel_launch: occupancy query says %d\n", per_cu); per_cu = 1; }
        (void)hipGetLastError();
        grid = cus;
    }
    if (grid < 0) return;
    (void)hipMemsetAsync((char*)d_ws + WS_CTL, 0, 64 * 1024, stream);
    Params p{};
    const float** pp = (const float**)&p;
    for (int i = 0; i < 29; ++i) pp[i] = (const float*)d_in[i];
    p.out = (float*)d_out; p.ws = (unsigned char*)d_ws;
    hipLaunchKernelGGL(fwd_megakernel, dim3(grid), dim3(NT), LDS_BYTES, stream, p);
}
```

```cpp
#include <hip/hip_runtime.h>
#include <cstdio>
#include <cstdint>

namespace pg8 {
#define PG8_LAS __attribute__((address_space(3)))
typedef unsigned short bf16_t;
typedef short bf16x8 __attribute__((ext_vector_type(8)));
typedef float f32x4 __attribute__((ext_vector_type(4)));
typedef unsigned u32x4 __attribute__((ext_vector_type(4)));
constexpr int BM = 256, BK = 64, HALF = 128, HTB = HALF * BK * 2, STAGE_BYTES = 8 * HTB, NXCD = 8, WGM = 8;

__host__ __device__ __forceinline__ int lds_byte(int r, int c) { const int st = (r >> 4) * 2 + (c >> 5), rr = r & 15, cc = c & 31, ob = rr * 64 + cc * 2; return st * 1024 + (ob ^ (((ob >> 9) & 1) << 5)); }
__host__ __device__ __forceinline__ void stage_rc(int b, int& R, int& C) { const int st = b / 1024, sb = b % 1024, swz = sb ^ (((sb >> 9) & 1) << 5); R = (st >> 1) * 16 + swz / 64; C = (st & 1) * 32 + (swz % 64) / 2; }
__host__ __device__ __forceinline__ int perm32(int rho) { const int n = rho >> 4, i = rho & 15; return 8 * (i >> 2) + 4 * n + (i & 3); }

struct Unit { int pm, pn; };
struct Gemm { const bf16_t* A; const bf16_t* A2; const bf16_t* Bt; };
template <int K_, int LDA_, int JS_, int TSPLIT_, int TMID_, int APN_> struct Cfg { static constexpr int K = K_, lda = LDA_, jstride = JS_, tsplit = TSPLIT_, tmid = TMID_, apn = APN_; };

struct StaticOrder {
    int nM, nN, nwg, G, c;
    __host__ __device__ void init(int M, int N, int G_, int c_) { nM = M / BM; nN = N / BM; nwg = nM * nN; G = G_; c = c_; }
    __host__ __device__ bool next(int i, Unit& u) const {
        const long L = (long)i * G + c; if (L >= nwg) return false;
        int wgid = (int)L; { const int q = nwg / NXCD, r = nwg % NXCD, xcd = wgid % NXCD, off = wgid / NXCD; wgid = (xcd < r ? xcd * (q + 1) : r * (q + 1) + (xcd - r) * q) + off; }
        const int nig = WGM * nN, gid = wgid / nig, fm = gid * WGM, gsz = (nM - fm) < WGM ? (nM - fm) : WGM;
        u.pm = fm + ((wgid % nig) % gsz); u.pn = (wgid % nig) / gsz; return true;
    }
};

__device__ __forceinline__ unsigned cvt_pk_bf16(float lo, float hi) { unsigned r; asm volatile("v_cvt_pk_bf16_f32 %0, %1, %2" : "=v"(r) : "v"(lo), "v"(hi)); return r; }

template <class CF, class Epi, class Sched>
__device__ __forceinline__ void gemm_phase(PG8_LAS unsigned char* lds, const Gemm g, const Sched& S, const Epi& E, int wv) {
    int tid_; asm volatile("v_mbcnt_lo_u32_b32 %0, -1, 0\n\tv_mbcnt_hi_u32_b32 %0, -1, %0" : "=v"(tid_)); tid_ += wv * 64; asm volatile("" : "+v"(tid_));
    const int tid = tid_, wid = __builtin_amdgcn_readfirstlane(tid >> 6), lane = tid & 63, wr = wid >> 2, wc = wid & 3, fr = lane & 15, fq = lane >> 4;
    constexpr int K = CF::K, nt = K / BK, tsplit = CF::tsplit;
    unsigned voffA[2], voffB[2];
#pragma unroll
    for (int i = 0; i < 2; ++i) { int R, C; stage_rc(tid * 16 + i * 8192, R, C); const int Rb = Epi::PERM ? ((R & ~31) + perm32(R & 31)) : R;
        voffA[i] = (unsigned)(R * CF::lda + (C >> 4) * CF::jstride + (C & 15)) * 2u; voffB[i] = (unsigned)(Rb * K + C) * 2u; }
    constexpr size_t kstepA = (size_t)CF::jstride * 8, kstepB = (size_t)(BK * 2);
    constexpr size_t hstepA = (size_t)HALF * CF::lda * 2, hstepB = (size_t)HALF * K * 2;
    constexpr size_t tstepA = 2 * hstepA, tstepB = 2 * hstepB, apnb = (size_t)CF::apn * 2;
    const unsigned ldsw = (unsigned)wid * 1024u;
    const int aoff = lds_byte(wr * 64 + fr, fq * 8), boff = lds_byte(wc * 32 + fr, fq * 8);
#define PG8_SA(b, h) (((b) * 2 + (h)) * HTB)
#define PG8_SB(b, h) ((4 + (b) * 2 + (h)) * HTB)
#define PG8_STAGE(bufoff, gbase, voff) do { _Pragma("unroll") for (int _i = 0; _i < 2; ++_i) \
        __builtin_amdgcn_global_load_lds((const unsigned*)((const char*)(gbase) + (voff)[_i]), (PG8_LAS unsigned*)(lds + (bufoff) + ldsw + _i * 8192), 16, 0, 0); } while (0)
#define PG8_LDA(dst, b, h) do { _Pragma("unroll") for (int m = 0; m < 4; ++m) _Pragma("unroll") for (int k = 0; k < 2; ++k) dst[m][k] = *(const PG8_LAS bf16x8*)(lds + PG8_SA(b, h) + aoff + m * 2048 + k * 1024); } while (0)
#define PG8_LDB(dst, b, h) do { _Pragma("unroll") for (int n = 0; n < 2; ++n) _Pragma("unroll") for (int k = 0; k < 2; ++k) dst[n][k] = *(const PG8_LAS bf16x8*)(lds + PG8_SB(b, h) + boff + n * 2048 + k * 1024); } while (0)
#define PG8_MMA(ai, bj, At, Bt) do { __builtin_amdgcn_s_setprio(1); _Pragma("unroll") for (int m = 0; m < 4; ++m) _Pragma("unroll") for (int n = 0; n < 2; ++n) _Pragma("unroll") for (int k = 0; k < 2; ++k) \
        acc[ai][bj][m][n] = __builtin_amdgcn_mfma_f32_16x16x32_bf16(Bt[n][k], At[m][k], acc[ai][bj][m][n], 0, 0, 0); __builtin_amdgcn_s_setprio(0); } while (0)
#define PG8_WAIT_V(n) asm volatile("s_waitcnt vmcnt(" #n ")" ::: "memory")
#define PG8_WAIT_L(n) asm volatile("s_waitcnt lgkmcnt(" #n ")" ::: "memory")
#define PG8_BAR __builtin_amdgcn_s_barrier()
#define PG8_SCHED __builtin_amdgcn_sched_barrier(0)
#define PG8_UA(u)  ((const char*)g.A  + (size_t)(u).pm * tstepA + (size_t)(u).pn * apnb)
#define PG8_UA2(u) ((const char*)g.A2 + (size_t)(u).pm * tstepA + (size_t)(u).pn * apnb - (size_t)tsplit * kstepA)
    Unit cur, nxt; int ui = 0;
    if (!S.next(0, cur)) return;
    f32x4 acc[2][2][4][2];
#pragma unroll
    for (int a = 0; a < 2; ++a)
#pragma unroll
        for (int b = 0; b < 2; ++b)
#pragma unroll
            for (int m = 0; m < 4; ++m)
#pragma unroll
                for (int n = 0; n < 2; ++n) acc[a][b][m][n] = (f32x4){0.f, 0.f, 0.f, 0.f};
    bf16x8 At[4][2], B0[2][2], B1[2][2];
    const char* cA = PG8_UA(cur); const char* cA2 = PG8_UA2(cur); const char* cB = (const char*)g.Bt + (size_t)cur.pn * tstepB;
    PG8_STAGE(PG8_SB(0, 0), cB, voffB); PG8_STAGE(PG8_SB(0, 1), cB + hstepB, voffB); PG8_STAGE(PG8_SA(0, 0), cA, voffA); PG8_STAGE(PG8_SA(0, 1), cA + hstepA, voffA);
    if (wr == 1) PG8_BAR;
    PG8_WAIT_V(2); PG8_BAR;
    PG8_STAGE(PG8_SB(1, 0), cB + kstepB, voffB); PG8_STAGE(PG8_SA(1, 0), cA + kstepA, voffA); PG8_STAGE(PG8_SB(1, 1), cB + hstepB + kstepB, voffB);
    PG8_WAIT_V(6); PG8_BAR;
    for (;;) {
        const bool has_next = S.next(ui + 1, nxt);
        const char* nA = has_next ? PG8_UA(nxt) : cA; const char* nB = has_next ? (const char*)g.Bt + (size_t)nxt.pn * tstepB : cB;
        for (int t = 0; t < nt; t += 2) {
            if constexpr (Epi::MID) { if (t == CF::tmid) E.mid(acc, cur, wr, wc, fr, fq); }
            const bool last = (t == nt - 2);
            const char* a1 = ((t + 1 < tsplit) ? cA : cA2) + (size_t)(t + 1) * kstepA;
            const char* a2 = last ? nA : ((t + 2 < tsplit) ? cA : cA2) + (size_t)(t + 2) * kstepA;
            const char* b2 = last ? nB : cB + (size_t)(t + 2) * kstepB;
            const char* a3 = a2 + kstepA; const char* b3 = b2 + kstepB;
            PG8_LDB(B0, 0, 0); PG8_LDB(B1, 0, 1); PG8_SCHED; PG8_LDA(At, 0, 0); PG8_STAGE(PG8_SA(1, 1), a1 + hstepA, voffA);
            PG8_WAIT_V(8); PG8_WAIT_L(0); PG8_BAR; PG8_MMA(0, 0, At, B0); PG8_MMA(0, 1, At, B1); PG8_BAR; PG8_SCHED;
            PG8_LDA(At, 0, 1); PG8_STAGE(PG8_SB(0, 0), b2, voffB); PG8_STAGE(PG8_SB(0, 1), b2 + hstepB, voffB); PG8_STAGE(PG8_SA(0, 0), a2, voffA);
            PG8_WAIT_V(8); PG8_WAIT_L(0); PG8_BAR; PG8_MMA(1, 0, At, B0); PG8_MMA(1, 1, At, B1); PG8_BAR; PG8_SCHED;
            PG8_LDB(B0, 1, 0); PG8_LDB(B1, 1, 1); PG8_SCHED; PG8_LDA(At, 1, 0); PG8_STAGE(PG8_SA(0, 1), a2 + hstepA, voffA);
            PG8_WAIT_V(8); PG8_WAIT_L(0); PG8_BAR; PG8_MMA(0, 0, At, B0); PG8_MMA(0, 1, At, B1); PG8_BAR; PG8_SCHED;
            PG8_LDA(At, 1, 1); PG8_STAGE(PG8_SB(1, 0), b3, voffB); PG8_STAGE(PG8_SB(1, 1), b3 + hstepB, voffB); PG8_STAGE(PG8_SA(1, 0), a3, voffA);
            PG8_WAIT_V(8); PG8_WAIT_L(0); PG8_BAR; PG8_MMA(1, 0, At, B0); PG8_MMA(1, 1, At, B1); PG8_BAR; PG8_SCHED;
        }
        if (wr == 0) PG8_BAR;
        E(acc, cur, wr, wc, fr, fq);
        if (!has_next) break;
#pragma unroll
        for (int a = 0; a < 2; ++a)
#pragma unroll
            for (int b = 0; b < 2; ++b)
#pragma unroll
                for (int m = 0; m < 4; ++m)
#pragma unroll
                    for (int n = 0; n < 2; ++n) acc[a][b][m][n] = (f32x4){0.f, 0.f, 0.f, 0.f};
        cur = nxt; cA = nA; cA2 = PG8_UA2(cur); cB = nB; ++ui;
        if (wr == 1) PG8_BAR;
    }
    PG8_WAIT_V(0);
    PG8_BAR;
#undef PG8_SA
#undef PG8_SB
#undef PG8_STAGE
#undef PG8_LDA
#undef PG8_LDB
#undef PG8_MMA
#undef PG8_WAIT_V
#undef PG8_WAIT_L
#undef PG8_BAR
#undef PG8_SCHED
#undef PG8_UA
#undef PG8_UA2
}
}

constexpr int NWAVES = 8, NT = NWAVES * 64;
constexpr int D = 1024, SEQ = 16384, CTXN = 256, MR = SEQ + CTXN  ;
constexpr int SSMW = 512, NG = 32, NP = 64, FF = 2816, WIN = 4608, NMOD = 6 * D;
constexpr int NCH = MR / 16  , NCHP = 1280  ;
constexpr float EPS = 1e-6f;
constexpr size_t MiB = 1u << 20;
constexpr size_t WS_CTL = 0;
constexpr size_t WS_MOD = 64 * 1024;
constexpr size_t WS_A16 = 192 * 1024;
constexpr size_t WS_POSR = 256 * 1024, WS_POSC = 768 * 1024 + 0;
constexpr size_t WS_XC = 1 * MiB;
constexpr size_t WS_APOW = 2 * MiB;
constexpr size_t WS_BTC = 3 * MiB + 256 * 1024;
constexpr size_t WS_SS = 4 * MiB + 512 * 1024;
constexpr size_t WS_CV = 5 * MiB;
constexpr size_t WS_GV = 5 * MiB + 512 * 1024;
constexpr int NCV = WIN + 2 * FF;
constexpr size_t WS_WIN = 6 * MiB, WS_WGLU = 15 * MiB, WS_WPROJ = 15 * MiB + 512 * 1024, WS_WOUT = 18 * MiB + 512 * 1024;
constexpr size_t WS_BAM = 20 * MiB + 512 * 1024, WS_TC = 24 * MiB + 512 * 1024;
constexpr size_t WS_XR = 32 * MiB + 512 * 1024;
constexpr size_t WS_U = 65 * MiB, WS_HST = 81 * MiB + 256 * 1024;
constexpr size_t WS_WGU = 65 * MiB, WS_WD = 76 * MiB;
constexpr size_t WS_VB = 97 * MiB + 512 * 1024;
constexpr size_t WS_SA = 130 * MiB, WS_SB = 162 * MiB + 512 * 1024;
constexpr size_t WS_A2 = 195 * MiB;
constexpr size_t WS_HID = WS_VB;
constexpr size_t WS_BAM1 = 244 * MiB, WS_TC1 = 248 * MiB;
constexpr size_t WS_END = 256 * MiB;
static_assert(WS_HID + (size_t)MR * FF * 2 <= WS_A2, "hid overlay");
static_assert(WS_A2 + (size_t)MR * 1536 * 2 <= WS_END, "a2");
static_assert(WS_WD + (size_t)D * FF * 2 <= WS_VB, "wd");
static_assert(WS_BTC + 8192 * 32 * 4 <= WS_WIN && WS_APOW + 8192 * 34 * 4 <= WS_BTC, "small");

constexpr int LDS_BYTES = 147456, MISC_OFF = 131072 + 320;

#define LAS __attribute__((address_space(3)))
__device__ __forceinline__ int lane_id_v() { int l; asm volatile("v_mbcnt_lo_u32_b32 %0, -1, 0\n\tv_mbcnt_hi_u32_b32 %0, -1, %0" : "=v"(l)); return l; }
__device__ __forceinline__ int tid_of(int wv) { return wv * 64 + lane_id_v(); }
typedef unsigned short bf16;
typedef unsigned v4u __attribute__((ext_vector_type(4)));
typedef unsigned v2u __attribute__((ext_vector_type(2)));
typedef float f32x4 __attribute__((ext_vector_type(4)));
typedef float f32x2 __attribute__((ext_vector_type(2)));
using pg8::cvt_pk_bf16;

__device__ __forceinline__ float bf_lo(unsigned u) { return __uint_as_float(u << 16); }
__device__ __forceinline__ float bf_hi(unsigned u) { return __uint_as_float(u & 0xffff0000u); }
__device__ __forceinline__ unsigned f2bf(float f) { unsigned u = __float_as_uint(f); return (u + 0x7fffu + ((u >> 16) & 1u)) >> 16; }
__device__ __forceinline__ float sigm(float x) { return __builtin_amdgcn_rcpf(1.0f + __expf(-x)); }
__device__ __forceinline__ float silu_f(float x) { return x * sigm(x); }
__device__ __forceinline__ float gelu_tanh(float x) { return x * sigm(1.5957691216057308f * (x + 0.044715f * x * x * x)); }
__device__ __forceinline__ float wave_sum(float v) {
#pragma unroll
    for (int o = 1; o < 64; o <<= 1) v += __shfl_xor(v, o);
    return v;
}
__device__ __forceinline__ void sincos_cw(float x, float& s, float& c) {
    const float kf = rintf(x * 0.63661977236758134f);
    float r = fmaf(-kf, 1.5703125f, x); r = fmaf(-kf, 4.837512969970703125e-4f, r); r = fmaf(-kf, 7.54978995489188216e-8f, r);
    const float r2 = r * r;
    float sp = fmaf(r2, 2.7557319e-6f, -1.9841270e-4f); sp = fmaf(sp, r2, 8.3333333e-3f); sp = fmaf(sp, r2, -1.6666667e-1f); sp = fmaf(sp * r2, r, r);
    float cp = fmaf(r2, -2.7557319e-7f, 2.4801587e-5f); cp = fmaf(cp, r2, -1.3888889e-3f); cp = fmaf(cp, r2, 4.1666667e-2f); cp = fmaf(cp, r2, -0.5f); cp = fmaf(cp, r2, 1.0f);
    const int q = ((int)kf) & 3;
    const float ss = (q & 1) ? cp : sp, cc = (q & 1) ? sp : cp;
    s = (q & 2) ? -ss : ss; c = ((q + 1) & 2) ? -cc : cc;
}

struct Params {
    const float *x, *c, *ctx, *c_ctx, *w_mod, *b_mod, *norm1_g, *norm2_g, *w_in, *lam_re, *lam_im, *log_step, *b_re, *b_im, *c_re, *c_im, *ssm_d,
        *w_glu, *w_proj_a, *dw_kernel, *dw_bias, *cn_g, *cn_b, *w_proj_b, *w_out, *w_gate, *w_up, *w_down, *norm_f_g;
    float* out; unsigned char* ws;
};
__device__ __forceinline__ Params load_params() {
    Params p{};
#if defined(__HIP_DEVICE_COMPILE__)
    typedef const void* cvp;
    const __attribute__((address_space(4))) cvp* kp = (const __attribute__((address_space(4))) cvp*)__builtin_amdgcn_kernarg_segment_ptr(); asm volatile("" : "+s"(kp));
    cvp* dst = (cvp*)&p;
#pragma unroll
    for (int i = 0; i < 31; ++i) dst[i] = kp[i];
#endif
    return p;
}

#define XB_TMO      128
#define XB_XCNT(j)  (256  + 64 * (j))
#define XB_XSUB(j)  (1280 + 64 * (j))
#define XB_XGEN(j)  (2304 + 64 * (j))
#define XB_TOP      3328
#define XB_TOPGEN   3392
#define XCD_BAR_WORDS 3456
#define XB_SPIN_CAP (1u << 18)
__device__ __forceinline__ unsigned xb_ld(unsigned* p)              { return __hip_atomic_load(p, __ATOMIC_RELAXED, __HIP_MEMORY_SCOPE_AGENT); }
__device__ __forceinline__ unsigned xb_add(unsigned* p, unsigned v) { return __hip_atomic_fetch_add(p, v, __ATOMIC_RELAXED, __HIP_MEMORY_SCOPE_AGENT); }
__device__ __forceinline__ unsigned xb_xcc_id() { return (unsigned)__builtin_amdgcn_s_getreg((3 << 11) | 20) & 0xFu; }
#define XB_SPIN(cond, bar) do { unsigned _sp = 0; while (cond) { __builtin_amdgcn_s_sleep(1); \
    if ((++_sp & 255u) == 0u) { if (xb_ld(&(bar)[XB_TMO])) break; if (_sp > XB_SPIN_CAP) { atomicAdd(&(bar)[XB_TMO], 1u); break; } } } } while (0)
struct XcdBarrier { unsigned* bar; unsigned x; volatile LAS unsigned* st; int wv; };
__device__ __forceinline__ XcdBarrier xcd_barrier_post(unsigned* bar, volatile LAS unsigned* st, int wv) {
    XcdBarrier b; b.bar = bar; b.x = xb_xcc_id(); b.st = st; b.wv = wv;
    if (tid_of(wv) == 0) (void)xb_add(&bar[XB_XCNT(b.x)], 1u);
    return b;
}
__device__ __forceinline__ void xcd_barrier_complete(unsigned* bar, unsigned x, unsigned& nloc, unsigned& nx) {
    const unsigned G = gridDim.x * gridDim.y * gridDim.z;
    unsigned sum, cnt, mine, sp = 0u;
    for (;;) {
        sum = 0u; cnt = 0u; mine = 0u;
#pragma unroll
        for (unsigned j = 0; j < 16; ++j) { const unsigned c = xb_ld(&bar[XB_XCNT(j)]); sum += c; cnt += (c > 0u) ? 1u : 0u; mine = (j == x) ? c : mine; }
        if (sum == G) break;
        __builtin_amdgcn_s_sleep(1);
        if ((++sp & 255u) == 0u) { if (xb_ld(&bar[XB_TMO])) break; if (sp > XB_SPIN_CAP) { atomicAdd(&bar[XB_TMO], 1u); break; } }
    }
    nloc = mine > 0u ? mine : 1u; nx = cnt > 0u ? cnt : 1u;
}
__device__ __forceinline__ void xcd_barrier(const XcdBarrier& b0) {
    asm volatile("s_waitcnt vmcnt(0)" ::: "memory");
    __syncthreads();
    if (tid_of(b0.wv) == 0) {
        XcdBarrier b; b.bar = (unsigned*)(load_params().ws + WS_CTL); b.x = xb_xcc_id(); b.st = b0.st;
        unsigned* bar = b.bar;
        __builtin_amdgcn_s_waitcnt(0);
        unsigned nloc = b.st[0], nx = b.st[1];
        if (nloc == 0u) { xcd_barrier_complete(bar, b.x, nloc, nx); b.st[0] = nloc; b.st[1] = nx; }
        const unsigned old = xb_add(&bar[XB_XSUB(b.x)], 1u);
        const unsigned gen = old / nloc;
        if (old + 1u == (gen + 1u) * nloc) {
            __builtin_amdgcn_fence(__ATOMIC_RELEASE, "agent");
            asm volatile("s_waitcnt vmcnt(0)" ::: "memory");
            const unsigned og = xb_add(&bar[XB_TOP], 1u);
            const unsigned tg = og / nx;
            if (og + 1u == (tg + 1u) * nx) xb_add(&bar[XB_TOPGEN], 1u);
            else XB_SPIN(xb_ld(&bar[XB_TOPGEN]) == tg, bar);
            __builtin_amdgcn_fence(__ATOMIC_ACQUIRE, "agent");
            xb_add(&bar[XB_XGEN(b.x)], 1u);
            asm volatile("s_waitcnt vmcnt(0)" ::: "memory");
        } else {
            XB_SPIN(xb_ld(&bar[XB_XGEN(b.x)]) == gen, bar);
            __builtin_amdgcn_fence(__ATOMIC_ACQUIRE, "agent");
            asm volatile("s_waitcnt vmcnt(0)" ::: "memory");
        }
    }
    __syncthreads();
}

typedef pg8::f32x4 (AccT)[2][2][4][2];
#define FOR_AI_M _Pragma("unroll") for (int ai = 0; ai < 2; ++ai) _Pragma("unroll") for (int m = 0; m < 4; ++m)

struct EpiWin {
    static constexpr bool PERM = true, MID = false;
    bf16 *U, *VB, *SA, *SB; const float* SS; const float* CV;
    __device__ __forceinline__ void operator()(const AccT& acc, const pg8::Unit& u, int wr, int wc, int fr, int fq) const {
        const int row0 = u.pm * 256 + wr * 64 + fr, cl = wc * 32 + 8 * fq;
        const float* cv = CV + (u.pm >= 64 ? NCV : 0) + u.pn * 256 + cl;
        f32x4 c00 = *(const f32x4*)(cv), c01 = *(const f32x4*)(cv + 4), c10 = *(const f32x4*)(cv + 128), c11 = *(const f32x4*)(cv + 132);
        float rsv[2][4];
        FOR_AI_M rsv[ai][m] = SS[row0 + ai * 128 + m * 16];
        FOR_AI_M rsv[ai][m] = rsqrtf(rsv[ai][m] * (1.0f / D) + EPS);
        if (u.pn >= 2 && u.pn < 10) {
            FOR_AI_M { const int row = row0 + ai * 128 + m * 16; const float rs = rsv[ai][m];
                const f32x4 v0 = acc[ai][0][m][0] * rs + c00, v1 = acc[ai][0][m][1] * rs + c01, g0 = acc[ai][1][m][0] * rs + c10, g1 = acc[ai][1][m][1] * rs + c11;
                v4u w; w.x = cvt_pk_bf16(v0[0] * sigm(g0[0]), v0[1] * sigm(g0[1])); w.y = cvt_pk_bf16(v0[2] * sigm(g0[2]), v0[3] * sigm(g0[3]));
                w.z = cvt_pk_bf16(v1[0] * sigm(g1[0]), v1[1] * sigm(g1[1])); w.w = cvt_pk_bf16(v1[2] * sigm(g1[2]), v1[3] * sigm(g1[3]));
                *(v4u*)(VB + (size_t)row * 1024 + (u.pn - 2) * 128 + cl) = w; }
        } else {
            bf16* base; int ldc, colt; bool sg;
            if (u.pn < 2) { base = U; ldc = 512; colt = u.pn * 256; sg = false; }
            else if (u.pn < 14) { base = SA; ldc = 1024; colt = (u.pn - 10) * 256; sg = true; }
            else { base = SB; ldc = 1024; colt = (u.pn - 14) * 256; sg = true; }
            FOR_AI_M { const int row = row0 + ai * 128 + m * 16; const float rs = rsv[ai][m];
#pragma unroll
                for (int bj = 0; bj < 2; ++bj) { f32x4 v0 = acc[ai][bj][m][0] * rs + (bj ? c10 : c00), v1 = acc[ai][bj][m][1] * rs + (bj ? c11 : c01);
                    if (sg) { for (int i = 0; i < 4; ++i) { v0[i] = sigm(v0[i]); v1[i] = sigm(v1[i]); } }
                    v4u w; w.x = cvt_pk_bf16(v0[0], v0[1]); w.y = cvt_pk_bf16(v0[2], v0[3]); w.z = cvt_pk_bf16(v1[0], v1[1]); w.w = cvt_pk_bf16(v1[2], v1[3]);
                    *(v4u*)(base + (size_t)row * ldc + colt + bj * 128 + cl) = w; } }
        }
    }
};
struct EpiS1 {
    static constexpr bool PERM = false, MID = false;
    float* S;
    __device__ __forceinline__ void operator()(const AccT& acc, const pg8::Unit& u, int wr, int wc, int fr, int fq) const {
        float* sp = S + (size_t)(u.pm * 256 + wr * 64 + fr) * 8192 + u.pn * 256 + wc * 32 + 4 * fq;
        if (u.pm < 4) {
            FOR_AI_M {
#pragma unroll
                for (int bj = 0; bj < 2; ++bj)
#pragma unroll
                    for (int n = 0; n < 2; ++n) *(f32x4*)(sp + (size_t)(ai * 128 + m * 16) * 8192 + bj * 128 + n * 16) = acc[ai][bj][m][n]; asm volatile("" ::: "memory"); }
        } else if (wr == 0) {
#pragma unroll
            for (int bj = 0; bj < 2; ++bj)
#pragma unroll
                for (int n = 0; n < 2; ++n) *(f32x4*)(sp + bj * 128 + n * 16) = acc[0][bj][0][n];
        }
    }
};
struct EpiS3 {
    static constexpr bool PERM = true, MID = false;
    bf16* YA;
    __device__ __forceinline__ void operator()(const AccT& acc, const pg8::Unit& u, int wr, int wc, int fr, int fq) const {
        const int row0 = u.pm * 256 + wr * 64 + fr;
        FOR_AI_M { const int chunk = row0 + ai * 128 + m * 16;
#pragma unroll
            for (int bj = 0; bj < 2; ++bj) { const int col8 = bj * 128 + wc * 32 + 8 * fq, t = col8 >> 4, ch = u.pn * 16 + (col8 & 15);
                const f32x4 a0 = acc[ai][bj][m][0], a1 = acc[ai][bj][m][1];
                v4u w; w.x = cvt_pk_bf16(gelu_tanh(a0[0]), gelu_tanh(a0[1])); w.y = cvt_pk_bf16(gelu_tanh(a0[2]), gelu_tanh(a0[3]));
                w.z = cvt_pk_bf16(gelu_tanh(a1[0]), gelu_tanh(a1[1])); w.w = cvt_pk_bf16(gelu_tanh(a1[2]), gelu_tanh(a1[3]));
                *(v4u*)(YA + (size_t)(chunk * 16 + t) * 512 + ch) = w; } asm volatile("" ::: "memory"); }
    }
};
struct EpiGlu {
    static constexpr bool PERM = true, MID = false;
    const bf16* YA; bf16* A2;
    __device__ __forceinline__ void operator()(const AccT& acc, const pg8::Unit& u, int wr, int wc, int fr, int fq) const {
        const int row0 = u.pm * 256 + wr * 64 + fr, col0 = u.pn * 256 + wc * 32 + 8 * fq;
        v4u yv[2][4][2];
        FOR_AI_M { const int row = row0 + ai * 128 + m * 16;
#pragma unroll
            for (int bj = 0; bj < 2; ++bj) yv[ai][m][bj] = *(const v4u*)(YA + (size_t)row * 512 + col0 + bj * 128); }
        FOR_AI_M { const int row = row0 + ai * 128 + m * 16;
#pragma unroll
            for (int bj = 0; bj < 2; ++bj) { const int col = col0 + bj * 128; const v4u y = yv[ai][m][bj]; const f32x4 a0 = acc[ai][bj][m][0], a1 = acc[ai][bj][m][1];
                v4u w; w.x = cvt_pk_bf16(bf_lo(y.x) * sigm(a0[0]), bf_hi(y.x) * sigm(a0[1])); w.y = cvt_pk_bf16(bf_lo(y.y) * sigm(a0[2]), bf_hi(y.y) * sigm(a0[3]));
                w.z = cvt_pk_bf16(bf_lo(y.z) * sigm(a1[0]), bf_hi(y.z) * sigm(a1[1])); w.w = cvt_pk_bf16(bf_lo(y.w) * sigm(a1[2]), bf_hi(y.w) * sigm(a1[3]));
                *(v4u*)(A2 + (size_t)row * 1536 + col) = w; } }
    }
};
struct EpiMerged {
    static constexpr bool PERM = true, MID = true;
    const bf16 *SA, *SB; bf16* MG;
    __device__ __forceinline__ void mid(AccT& acc, const pg8::Unit& u, int wr, int wc, int fr_, int fq_) const {
        int fr = fr_, fq = fq_; asm volatile("" : "+v"(fr), "+v"(fq));
        const int row0 = u.pm * 256 + wr * 64 + fr, col0 = u.pn * 256 + wc * 32 + 8 * fq;
        FOR_AI_M { const int row = row0 + ai * 128 + m * 16;
#pragma unroll
            for (int bj = 0; bj < 2; ++bj) { const size_t off = (size_t)row * 1024 + col0 + bj * 128; const v4u a = *(const v4u*)(SA + off), b = *(const v4u*)(SB + off);
                f32x4& a0 = acc[ai][bj][m][0]; f32x4& a1 = acc[ai][bj][m][1];
                a0[0] *= bf_lo(a.x) * __builtin_amdgcn_rcpf(bf_lo(b.x)); a0[1] *= bf_hi(a.x) * __builtin_amdgcn_rcpf(bf_hi(b.x));
                a0[2] *= bf_lo(a.y) * __builtin_amdgcn_rcpf(bf_lo(b.y)); a0[3] *= bf_hi(a.y) * __builtin_amdgcn_rcpf(bf_hi(b.y));
                a1[0] *= bf_lo(a.z) * __builtin_amdgcn_rcpf(bf_lo(b.z)); a1[1] *= bf_hi(a.z) * __builtin_amdgcn_rcpf(bf_hi(b.z));
                a1[2] *= bf_lo(a.w) * __builtin_amdgcn_rcpf(bf_lo(b.w)); a1[3] *= bf_hi(a.w) * __builtin_amdgcn_rcpf(bf_hi(b.w)); } asm volatile("" ::: "memory"); }
    }
    __device__ __forceinline__ void operator()(const AccT& acc, const pg8::Unit& u, int wr, int wc, int fr, int fq) const {
        const int row0 = u.pm * 256 + wr * 64 + fr, col0 = u.pn * 256 + wc * 32 + 8 * fq;
        v4u bv[2][4][2];
        FOR_AI_M { const int row = row0 + ai * 128 + m * 16;
#pragma unroll
            for (int bj = 0; bj < 2; ++bj) bv[ai][m][bj] = *(const v4u*)(SB + (size_t)row * 1024 + col0 + bj * 128); }
        FOR_AI_M { const int row = row0 + ai * 128 + m * 16;
#pragma unroll
            for (int bj = 0; bj < 2; ++bj) { const size_t off = (size_t)row * 1024 + col0 + bj * 128; const v4u b = bv[ai][m][bj]; const f32x4 a0 = acc[ai][bj][m][0], a1 = acc[ai][bj][m][1];
                v4u w; w.x = cvt_pk_bf16(a0[0] * bf_lo(b.x), a0[1] * bf_hi(b.x)); w.y = cvt_pk_bf16(a0[2] * bf_lo(b.y), a0[3] * bf_hi(b.y));
                w.z = cvt_pk_bf16(a1[0] * bf_lo(b.z), a1[1] * bf_hi(b.z)); w.w = cvt_pk_bf16(a1[2] * bf_lo(b.w), a1[3] * bf_hi(b.w));
                *(v4u*)(MG + off) = w; } }
    }
};
template <bool XG, bool FIRST = false> struct EpiRes {
    static constexpr bool PERM = false, MID = false;
    float* X; const float* gate; const float* gv; bf16* XGo; float* SSo; const float* Xin; const float* posr; const float* posc;
    __device__ __forceinline__ void operator()(const AccT& acc, const pg8::Unit& u, int wr, int wc, int fr, int fq) const {
        const int row0 = u.pm * 256 + wr * 64 + fr, col0 = u.pn * 256 + wc * 32 + 4 * fq;
        const float* XL = FIRST ? Xin : X;
        const float* ptab = (u.pn < 2) ? posr + col0 : posc + (col0 - 512);
        f32x4 gg[2][2], gw[2][2];
#pragma unroll
        for (int bj = 0; bj < 2; ++bj)
#pragma unroll
            for (int n = 0; n < 2; ++n) { gg[bj][n] = *(const f32x4*)(gate + col0 + bj * 128 + n * 16); if (XG) gw[bj][n] = *(const f32x4*)(gv + col0 + bj * 128 + n * 16); }
        f32x4 cur[2][2], nxt[2][2];
        { const float* rp = XL + (size_t)row0 * D + col0; const float* pp = ptab + (size_t)((u.pn < 2) ? (row0 >> 6) : (row0 & 63)) * 512;
#pragma unroll
          for (int bj = 0; bj < 2; ++bj)
#pragma unroll
              for (int n = 0; n < 2; ++n) { cur[bj][n] = *(const f32x4*)(rp + bj * 128 + n * 16); if (FIRST) cur[bj][n] += *(const f32x4*)(pp + bj * 128 + n * 16); } }
#pragma unroll
        for (int it = 0; it < 8; ++it) { const int ai = it >> 2, m = it & 3; const int row = row0 + ai * 128 + m * 16; float* rp = X + (size_t)row * D + col0;
            if (it < 7) { const int r2 = row0 + ((it + 1) >> 2) * 128 + ((it + 1) & 3) * 16; const float* rn = XL + (size_t)r2 * D + col0; const float* pp = ptab + (size_t)((u.pn < 2) ? (r2 >> 6) : (r2 & 63)) * 512;
#pragma unroll
                for (int bj = 0; bj < 2; ++bj)
#pragma unroll
                    for (int n = 0; n < 2; ++n) { nxt[bj][n] = *(const f32x4*)(rn + bj * 128 + n * 16); if (FIRST) nxt[bj][n] += *(const f32x4*)(pp + bj * 128 + n * 16); } }
            asm volatile("" ::: "memory");
            float ss = 0.f;
#pragma unroll
            for (int bj = 0; bj < 2; ++bj)
#pragma unroll
                for (int n = 0; n < 2; ++n) { const f32x4 xv = cur[bj][n] + gg[bj][n] * acc[ai][bj][m][n]; *(f32x4*)(rp + bj * 128 + n * 16) = xv;
                    if (XG) { ss += (xv[0] * xv[0] + xv[1] * xv[1]) + (xv[2] * xv[2] + xv[3] * xv[3]); const f32x4 y = xv * gw[bj][n];
                        v2u w; w.x = cvt_pk_bf16(y[0], y[1]); w.y = cvt_pk_bf16(y[2], y[3]); *(v2u*)(XGo + (size_t)row * D + col0 + bj * 128 + n * 16) = w; } }
            if (XG) { ss += __shfl_xor(ss, 16); ss += __shfl_xor(ss, 32); if (fq == 0) atomicAdd(SSo + row, ss); }
            asm volatile("" ::: "memory");
#pragma unroll
            for (int bj = 0; bj < 2; ++bj)
#pragma unroll
                for (int n = 0; n < 2; ++n) cur[bj][n] = nxt[bj][n]; }
    }
};
struct EpiFfn {
    static constexpr bool PERM = true, MID = false;
    bf16* H; const float* SS; const float* CV;
    __device__ __forceinline__ void operator()(const AccT& acc, const pg8::Unit& u, int wr, int wc, int fr, int fq) const {
        const int row0 = u.pm * 256 + wr * 64 + fr, col0 = u.pn * 128 + wc * 32 + 8 * fq;
        const float* cv = CV + (u.pm >= 64 ? NCV : 0) + u.pn * 256 + wc * 32 + 8 * fq;
        const f32x4 c00 = *(const f32x4*)(cv), c01 = *(const f32x4*)(cv + 4), c10 = *(const f32x4*)(cv + 128), c11 = *(const f32x4*)(cv + 132);
        float rsv[2][4];
        FOR_AI_M rsv[ai][m] = SS[row0 + ai * 128 + m * 16];
        FOR_AI_M rsv[ai][m] = rsqrtf(rsv[ai][m] * (1.0f / D) + EPS);
        FOR_AI_M { const int row = row0 + ai * 128 + m * 16; const float rs = rsv[ai][m];
            const f32x4 g0 = acc[ai][0][m][0] * rs + c00, g1 = acc[ai][0][m][1] * rs + c01, u0 = acc[ai][1][m][0] * rs + c10, u1 = acc[ai][1][m][1] * rs + c11;
            v4u w; w.x = cvt_pk_bf16(silu_f(g0[0]) * u0[0], silu_f(g0[1]) * u0[1]); w.y = cvt_pk_bf16(silu_f(g0[2]) * u0[2], silu_f(g0[3]) * u0[3]);
            w.z = cvt_pk_bf16(silu_f(g1[0]) * u1[0], silu_f(g1[1]) * u1[1]); w.w = cvt_pk_bf16(silu_f(g1[2]) * u1[2], silu_f(g1[3]) * u1[3]);
            *(v4u*)(H + (size_t)row * FF + col0) = w; }
    }
};

struct Ctx { int tid, lane, wave, G, bid, wv; unsigned char* lds; unsigned char* ws; };
__device__ __forceinline__ Ctx mkctx(unsigned char* lds, unsigned char* ws, int wv) { Ctx C; C.wv = wv; int t = tid_of(wv); asm volatile("" : "+v"(t)); C.tid = t; C.lane = t & 63; C.wave = __builtin_amdgcn_readfirstlane(t >> 6); C.G = gridDim.x; C.bid = blockIdx.x; asm volatile("" : "+s"(ws)); C.lds = lds; C.ws = ws; return C; }

__device__ __forceinline__ void transpose_item(const float* W, int N, bf16* WT, int ldk, int koff, int drow0, int k0, int n0, float* scr, int lane, const float* sh, float* cvo) {
    { float tv[32]; const float* wp = W + (size_t)(k0 + (lane >> 5)) * N + n0 + (lane & 31);
#pragma unroll
      for (int i = 0; i < 32; ++i) tv[i] = wp[(size_t)(2 * i) * N];
#pragma unroll
      for (int i = 0; i < 32; ++i) scr[(2 * i + (lane >> 5)) * 33 + (lane & 31)] = tv[i]; }
    asm volatile("s_waitcnt lgkmcnt(0)" ::: "memory");
    if (sh) {
        float a0 = 0.f, a1 = 0.f;
#pragma unroll 16
        for (int kk = 0; kk < 64; ++kk) { const float w = scr[kk * 33 + (lane & 31)]; a0 = fmaf(sh[k0 + kk], w, a0); a1 = fmaf(sh[NMOD + k0 + kk], w, a1); }
        if (lane < 32) { atomicAdd(cvo + drow0 + lane, a0); atomicAdd(cvo + NCV + drow0 + lane, a1); }
    }
    const int c = lane & 7;
#pragma unroll
    for (int j = 0; j < 4; ++j) { const int n = (lane >> 3) + 8 * j; const float* s = scr + (8 * c) * 33 + n;
        v4u o; o.x = cvt_pk_bf16(s[0 * 33], s[1 * 33]); o.y = cvt_pk_bf16(s[2 * 33], s[3 * 33]); o.z = cvt_pk_bf16(s[4 * 33], s[5 * 33]); o.w = cvt_pk_bf16(s[6 * 33], s[7 * 33]);
        *(v4u*)(WT + (size_t)(drow0 + n) * ldk + koff + k0 + 8 * c) = o; }
    asm volatile("s_waitcnt lgkmcnt(0)" ::: "memory");
}
__device__ __forceinline__ bool transpose_job(int& it, const float* W, int K, int N, bf16* WT, int ldk, int koff, int mode, float* scr, int lane, const float* sh = nullptr, float* cvo = nullptr) {
    const int nblk = N / 32, items = (K / 64) * nblk;
    if (it >= items) { it -= items; return false; }
    const int kb = it / nblk, nb = it % nblk, n0 = 32 * nb; int dr = n0;
    if (mode == 1) { if (n0 >= 512 && n0 < 1536) { const int c = n0 - 512; dr = 512 + (c >> 7) * 256 + (c & 127); } else if (n0 >= 1536 && n0 < 2560) { const int c = n0 - 1536; dr = 512 + (c >> 7) * 256 + 128 + (c & 127); } }
    else if (mode == 2) dr = (n0 >> 7) * 256 + (n0 & 127);
    else if (mode == 3) dr = (n0 >> 7) * 256 + 128 + (n0 & 127);
    transpose_item(W, N, WT, ldk, koff, dr, 64 * kb, n0, scr, lane, sh, cvo);
    return true;
}

__device__ __forceinline__ void rows_first(const Ctx& C0) {
    const Ctx C = mkctx(C0.lds, C0.ws, C0.wv); const Params P = load_params();
    const int gw = C.bid * NWAVES + C.wave, NGW = C.G * NWAVES, lane = C.lane;
    const float* modl = (const float*)(C.ws + WS_MOD);
    const float* posr = (const float*)(C.ws + WS_POSR); const float* posc = (const float*)(C.ws + WS_POSC);
    float* XC = (float*)(C.ws + WS_XC); float* SS = (float*)(C.ws + WS_SS); bf16* Hout = (bf16*)(C.ws + WS_XR);
    f32x4 gn[4];
#pragma unroll
    for (int j = 0; j < 4; ++j) gn[j] = *(const f32x4*)(P.norm1_g + 4 * lane + 256 * j);
    for (int row = gw; row < MR; row += NGW) {
        const bool isc = row >= SEQ; const float* mv = modl + (isc ? NMOD : 0);
        f32x4 v[4];
        if (isc) {
#pragma unroll
            for (int j = 0; j < 4; ++j) v[j] = *(const f32x4*)(P.ctx + (size_t)(row - SEQ) * D + 4 * lane + 256 * j);
        } else {
            const int pr = row >> 6, pc = row & 63;
#pragma unroll
            for (int j = 0; j < 4; ++j) { const int ch = 4 * lane + 256 * j; const f32x4 pe = (j < 2) ? *(const f32x4*)(posr + pr * 512 + ch) : *(const f32x4*)(posc + pc * 512 + ch - 512);
                v[j] = *(const f32x4*)(P.x + (size_t)row * D + ch) + pe; }
        }
        float* xo = isc ? XC + (size_t)(row - SEQ) * D : P.out + (size_t)row * D;
        float ss = 0.f;
#pragma unroll
        for (int j = 0; j < 4; ++j) { *(f32x4*)(xo + 4 * lane + 256 * j) = v[j]; ss += (v[j][0] * v[j][0] + v[j][1] * v[j][1]) + (v[j][2] * v[j][2] + v[j][3] * v[j][3]); }
        ss = wave_sum(ss); if (lane == 0) SS[row] = ss;
#pragma unroll
        for (int j = 0; j < 4; ++j) { const int ch = 4 * lane + 256 * j; const f32x4 sc = *(const f32x4*)(mv + D + ch);
            const f32x4 y = v[j] * gn[j] * (sc + 1.0f);
            v2u w; w.x = cvt_pk_bf16(y[0], y[1]); w.y = cvt_pk_bf16(y[2], y[3]);
            *(v2u*)(Hout + (size_t)row * D + ch) = w; }
    }
    for (int it = C.bid * NT + C.tid; it < 2 * 2 * 2 * D; it += C.G * NT) { const int k = it & (D - 1), nrm = (it >> 10) & 1, wh = (it >> 11) & 1, l = it >> 12;
        const float g = (nrm ? P.norm2_g : P.norm1_g)[l * D + k]; ((float*)(C.ws + WS_GV))[it] = g * (1.0f + modl[(size_t)(l * 2 + wh) * NMOD + (nrm ? 4 * D : D) + k]); }
}

__device__ __forceinline__ void phase_setup(const Ctx& C0) {
    const Ctx C = mkctx(C0.lds, C0.ws, C0.wv); const Params P = load_params(); (void)P;
    float* red = (float*)C.lds;
    for (int b = C.bid; b < 192; b += C.G) {
        const int l = b / 96, n0 = (b % 96) * 64, k0 = C.wave * 128;
        const float* W = P.w_mod + (size_t)l * D * NMOD + n0 + C.lane;
        float a0 = 0.f, a1 = 0.f;
#pragma unroll 32
        for (int k = 0; k < 128; ++k) { const float w = W[(size_t)(k0 + k) * NMOD]; a0 = fmaf(silu_f(P.c[k0 + k]), w, a0); a1 = fmaf(silu_f(P.c_ctx[k0 + k]), w, a1); }
        red[(C.wave * 2 + 0) * 64 + C.lane] = a0; red[(C.wave * 2 + 1) * 64 + C.lane] = a1;
        __syncthreads();
        if (C.wave < 2) { float s = 0.f;
#pragma unroll
            for (int w = 0; w < 8; ++w) s += red[(w * 2 + C.wave) * 64 + C.lane];
            ((float*)(C.ws + WS_MOD))[(size_t)(l * 2 + C.wave) * NMOD + n0 + C.lane] = s + P.b_mod[(size_t)l * NMOD + n0 + C.lane]; }
        __syncthreads();
    }
    const int gt = C.bid * NT + C.tid, NGT = C.G * NT;
    for (int it = gt; it < 4 * MR; it += NGT) ((float*)(C.ws + WS_SS))[it] = 0.f;
    for (int it = gt; it < 4 * NCV; it += NGT) ((float*)(C.ws + WS_CV))[it] = 0.f;
    for (int it = gt; it < 8192; it += NGT) {
        const float lr = P.lam_re[it], li = P.lam_im[it], dt = expf(P.log_step[it >> 6]);
        const float mag = expf(lr * dt); float sn, cs; sincos_cw(li * dt, sn, cs);
        const float ar = mag * cs, ai = mag * sn, nr = ar - 1.0f, ni = ai, den = lr * lr + li * li;
        const float fr_ = (nr * lr + ni * li) / den, fi_ = (ni * lr - nr * li) / den;
        float* ap = (float*)(C.ws + WS_APOW) + (size_t)it * 34; float pr = 1.f, pi = 0.f;
        for (int t = 0; t <= 16; ++t) { ap[2 * t] = pr; ap[2 * t + 1] = pi; const float qr = pr * ar - pi * ai, qi = pr * ai + pi * ar; if (t == 16) { ((float*)(C.ws + WS_A16))[2 * it] = pr; ((float*)(C.ws + WS_A16))[2 * it + 1] = pi; } pr = qr; pi = qi; }
        float* bt = (float*)(C.ws + WS_BTC) + (size_t)it * 32;
        for (int c = 0; c < 16; ++c) { const float br = P.b_re[(size_t)it * 16 + c], bi = P.b_im[(size_t)it * 16 + c]; bt[2 * c] = fr_ * br - fi_ * bi; bt[2 * c + 1] = fr_ * bi + fi_ * br; }
    }
    for (int it = gt; it < 320 * 256; it += NGT) {
        const int r = it >> 8, i = it & 255; const float om = 1.0f / powf(10000.0f, (float)i * (1.0f / 256.0f));
        const float pv = (float)(r < 256 ? r : r - 256); float sn, cs; sincos_cw(pv * om, sn, cs);
        float* T = (r < 256) ? (float*)(C.ws + WS_POSR) + (size_t)r * 512 : (float*)(C.ws + WS_POSC) + (size_t)(r - 256) * 512;
        T[i] = sn; T[256 + i] = cs;
    }
}

__device__ __forceinline__ void build_s5_mats(const Ctx& C0, int l, int sb, int sG) {
    const Ctx C = mkctx(C0.lds, C0.ws, C0.wv); const Params P = load_params(); (void)P;
    const int gt = sb * NT + C.tid, NGT = sG * NT;
    const float* apow = (const float*)(C.ws + WS_APOW) + (size_t)l * 4096 * 34;
    const float* btc = (const float*)(C.ws + WS_BTC) + (size_t)l * 4096 * 32;
    const float* cre = P.c_re + (size_t)l * 2 * NG * 16 * NP; const float* cim = P.c_im + (size_t)l * 2 * NG * 16 * NP;
    bf16* BAM = (bf16*)(C.ws + (l ? WS_BAM1 : WS_BAM)); bf16* TC = (bf16*)(C.ws + (l ? WS_TC1 : WS_TC));
    for (int it = gt; it < NG * 16 * 256; it += NGT) {
        const int cp = it & 15, c = (it >> 4) & 15, tau = (it >> 8) & 15, g = it >> 12;
        float kk[2];
#pragma unroll
        for (int d = 0; d < 2; ++d) { float s = 0.f; const float* cr = cre + ((size_t)(d * NG + g) * 16 + c) * NP; const float* ci = cim + ((size_t)(d * NG + g) * 16 + c) * NP;
            const float* ap = apow + (size_t)(d * NG + g) * NP * 34 + 2 * tau; const float* bt = btc + (size_t)(d * NG + g) * NP * 32 + 2 * cp;
#pragma unroll 16
            for (int p = 0; p < NP; ++p) { const float pr = ap[p * 34], pi = ap[p * 34 + 1], br = bt[p * 32], bi = bt[p * 32 + 1];
                const float zr = pr * br - pi * bi, zi = pr * bi + pi * br; s += cr[p] * zr - ci[p] * zi; }
            kk[d] = s; }
        bf16* T = TC + (size_t)g * 256 * 512;
        if (tau == 0) { const bf16 v = (bf16)f2bf(kk[0] + kk[1] + (c == cp ? P.ssm_d[(size_t)l * SSMW + g * 16 + c] : 0.f)); for (int t = 0; t < 16; ++t) T[(size_t)(t * 16 + c) * 512 + t * 16 + cp] = v; }
        else { const bf16 vf = (bf16)f2bf(kk[0]), vr = (bf16)f2bf(kk[1]);
            for (int t = tau; t < 16; ++t) { T[(size_t)(t * 16 + c) * 512 + (t - tau) * 16 + cp] = vf; T[(size_t)((t - tau) * 16 + c) * 512 + t * 16 + cp] = vr; } }
    }
    for (int it = gt; it < NG * 256 * 128; it += NGT) {
        const int p = it & 63, d = (it >> 6) & 1, c = (it >> 7) & 15, t = (it >> 11) & 15, g = it >> 15;
        const int e = d ? 16 - t : t + 1; const size_t ci_ = ((size_t)(d * NG + g) * 16 + c) * NP + p;
        const float cr = cre[ci_], ci = cim[ci_]; const float* ap = apow + ((size_t)(d * NG + g) * NP + p) * 34 + 2 * e;
        const float wr_ = cr * ap[0] - ci * ap[1], wi_ = cr * ap[1] + ci * ap[0];
        bf16* T = TC + ((size_t)g * 256 + t * 16 + c) * 512 + 256 + d * 128 + p;
        T[0] = (bf16)f2bf(wr_); T[64] = (bf16)f2bf(-wi_);
    }
    for (int it = gt; it < NG * 2 * NP * 256; it += NGT) {
        const int cp = it & 15, j = (it >> 4) & 15, p = (it >> 8) & 63, d = (it >> 14) & 1, g = it >> 15;
        const int e = d ? j : 15 - j; const float* ap = apow + ((size_t)(d * NG + g) * NP + p) * 34 + 2 * e; const float* bt = btc + ((size_t)(d * NG + g) * NP + p) * 32 + 2 * cp;
        const float vr = ap[0] * bt[0] - ap[1] * bt[1], vi = ap[0] * bt[1] + ap[1] * bt[0];
        bf16* B = BAM + ((size_t)g * 256 + d * 128 + p) * 256 + j * 16 + cp;
        B[0] = (bf16)f2bf(vr); B[(size_t)64 * 256] = (bf16)f2bf(vi);
    }
}

#define GAS __attribute__((address_space(1)))
template <int DIR, int N>
__device__ __forceinline__ void run_load(__amdgpu_buffer_rsrc_t RS, unsigned vs, float (&sr)[N], float (&si)[N]) {
    constexpr int STS = (DIR ? -8192 : 8192) * 4;
    const int bs = (int)(vs * 4u) + (DIR ? (N - 1) * STS : 0);
#pragma unroll
    for (int k = 0; k < N; ++k) { const int so = DIR ? (N - 1 - k) * (-STS) : k * STS; sr[k] = __builtin_bit_cast(float, __builtin_amdgcn_raw_buffer_load_b32(RS, bs, so, 0)); si[k] = __builtin_bit_cast(float, __builtin_amdgcn_raw_buffer_load_b32(RS, bs + 256, so, 0)); }
}
template <int DIR, int N, bool WRITE>
__device__ __forceinline__ void run_scan(__amdgpu_buffer_rsrc_t RH, unsigned vre, unsigned vim, const float (&sr)[N], const float (&si)[N], float ar, float ai, float& hr, float& hi) {
    constexpr int STH = (DIR ? -8192 : 8192) * 2;
    const int bre = (int)(vre * 2u) + (DIR ? (N - 1) * STH : 0), bim = (int)(vim * 2u) + (DIR ? (N - 1) * STH : 0);
#pragma unroll
    for (int k = 0; k < N; ++k) {
        if (WRITE) { const int so = DIR ? (N - 1 - k) * (-STH) : k * STH; __builtin_amdgcn_raw_buffer_store_b16((short)f2bf(hr), RH, bre, so, 0); __builtin_amdgcn_raw_buffer_store_b16((short)f2bf(hi), RH, bim, so, 0); }
        const float nr = ar * hr - ai * hi + sr[k], ni = ar * hi + ai * hr + si[k]; hr = nr; hi = ni; }
}
template <int DIR>
__device__ __forceinline__ void carry_scan_d(const Ctx& C, int l, int g) {
    constexpr int d = DIR; const int p = C.lane, w = C.wave;
    const __amdgpu_buffer_rsrc_t S = __builtin_amdgcn_make_buffer_rsrc((void*)(C.ws + WS_XR), 0, 0x7ffffffe, 0x00020000);
    const __amdgpu_buffer_rsrc_t H = __builtin_amdgcn_make_buffer_rsrc((void*)(C.ws + WS_HST), 0, 0x7ffffffe, 0x00020000);
    const float* a16p = (const float*)(C.ws + WS_A16) + 2 * ((size_t)((l * 2 + d) * NG + g) * NP + p);
    const float ar = a16p[0], ai = a16p[1];
    const int nre = d * 128 + p, nim = nre + 64;
    const unsigned ls = (unsigned)(g * 256 + d * 128 + p), lre = (unsigned)((nre >> 4) * 512 + g * 16 + (nre & 15)), lim = (unsigned)((nim >> 4) * 512 + g * 16 + (nim & 15));
    const int cc0 = DIR ? NCH - 1 : SEQ / 16;
    const int lc0 = DIR ? (SEQ / 16 - 1 - 128 * w) : 128 * w;
    constexpr int QS = DIR ? -32 : 32;
    const unsigned c0 = (unsigned)lc0 * 8192u, c1 = (unsigned)(lc0 + QS) * 8192u, c2 = (unsigned)(lc0 + 2 * QS) * 8192u, c3 = (unsigned)(lc0 + 3 * QS) * 8192u, cc = (unsigned)cc0 * 8192u;
    float* ends = (float*)C.lds;
    float er = 0.f, ei = 0.f, hr = 0.f, hi = 0.f;
    float q3r[32], q3i[32];
    {   float xr[16], xi[16], ar0[32], ai0[32], ar1[32], ai1[32];
        run_load<DIR, 16>(S, cc + ls, xr, xi); run_load<DIR, 32>(S, c0 + ls, ar0, ai0); run_load<DIR, 32>(S, c1 + ls, ar1, ai1);
        if (w == 0) run_scan<DIR, 16, true>(H, cc + lre, cc + lim, xr, xi, ar, ai, er, ei); else run_scan<DIR, 16, false>(H, 0u, 0u, xr, xi, ar, ai, er, ei);
        run_scan<DIR, 32, false>(H, 0u, 0u, ar0, ai0, ar, ai, hr, hi); run_scan<DIR, 32, false>(H, 0u, 0u, ar1, ai1, ar, ai, hr, hi); }
    {   float br[32], bi[32];
        run_load<DIR, 32>(S, c2 + ls, br, bi); run_load<DIR, 32>(S, c3 + ls, q3r, q3i);
        run_scan<DIR, 32, false>(H, 0u, 0u, br, bi, ar, ai, hr, hi); run_scan<DIR, 32, false>(H, 0u, 0u, q3r, q3i, ar, ai, hr, hi); }
    ends[(w * 64 + p) * 2] = hr; ends[(w * 64 + p) * 2 + 1] = hi;
    float pr = ar, pi = ai;
#pragma unroll
    for (int i = 0; i < 7; ++i) { const float qr = pr * pr - pi * pi, qi = 2.f * pr * pi; pr = qr; pi = qi; }
    float ar0[32], ai0[32], ar1[32], ai1[32];
    run_load<DIR, 32>(S, c0 + ls, ar0, ai0); run_load<DIR, 32>(S, c1 + ls, ar1, ai1);
    __syncthreads();
    hr = er; hi = ei;
    for (int ww = 0; ww < w; ++ww) { const float xr = ends[(ww * 64 + p) * 2], xi = ends[(ww * 64 + p) * 2 + 1]; const float nr = pr * hr - pi * hi + xr, ni = pr * hi + pi * hr + xi; hr = nr; hi = ni; }
    run_scan<DIR, 32, true>(H, c0 + lre, c0 + lim, ar0, ai0, ar, ai, hr, hi);
    { float br[32], bi[32]; run_load<DIR, 32>(S, c2 + ls, br, bi);
      run_scan<DIR, 32, true>(H, c1 + lre, c1 + lim, ar1, ai1, ar, ai, hr, hi);
      run_scan<DIR, 32, true>(H, c2 + lre, c2 + lim, br, bi, ar, ai, hr, hi); }
    run_scan<DIR, 32, true>(H, c3 + lre, c3 + lim, q3r, q3i, ar, ai, hr, hi);
    __syncthreads();
}
__device__ __forceinline__ void carry_scan(const Ctx& C0, int l, int gd) {
    const Ctx C = mkctx(C0.lds, C0.ws, C0.wv);
    if (gd & 1) carry_scan_d<1>(C, l, gd >> 1); else carry_scan_d<0>(C, l, gd >> 1);
}

template <int RR> struct ConvStep {
    static __device__ __forceinline__ void run(f32x2 (&acc)[32], const f32x2 (&wk)[31], const GAS bf16* VB, int r0, int len) {
        ConvStep<RR - 1>::run(acc, wk, VB, r0, len);
        const int ir = r0 - 15 + RR, irc = ir < 0 ? 0 : (ir >= len ? len - 1 : ir);
        unsigned raw = *(const GAS unsigned*)(VB + (size_t)irc * D); raw = (ir == irc) ? raw : 0u;
        const f32x2 v = (f32x2){bf_lo(raw), bf_hi(raw)};
        constexpr int J0 = RR - 30 > 0 ? RR - 30 : 0, J1 = RR < 31 ? RR : 31;
#pragma unroll
        for (int j = J0; j <= J1; ++j) acc[j] += v * wk[RR - j];
    }
};
template <> struct ConvStep<-1> { static __device__ __forceinline__ void run(f32x2 (&)[32], const f32x2 (&)[31], const GAS bf16*, int, int) {} };
__device__ __forceinline__ void conv_tile(const Ctx& C0, int l, int tile) {
    const Ctx C = mkctx(C0.lds, C0.ws, C0.wv); const Params P = load_params();
    const int tid = C.tid; const bool isc = tile >= SEQ / 32; const int base = isc ? SEQ : 0, len = isc ? CTXN : SEQ, r0 = (isc ? tile - SEQ / 32 : tile) * 32;
    const GAS bf16* VB = (const GAS bf16*)(C.ws + WS_VB) + (size_t)base * D + 2 * tid;
    const float* dw = P.dw_kernel + (size_t)l * 31 * D + 2 * tid;
    f32x2 wk[31];
#pragma unroll
    for (int k = 0; k < 31; ++k) wk[k] = *(const f32x2*)(dw + (size_t)k * D);
    const f32x2 bias = *(const f32x2*)(P.dw_bias + (size_t)l * D + 2 * tid);
    f32x2 acc[32];
#pragma unroll
    for (int j = 0; j < 32; ++j) acc[j] = bias;
    ConvStep<61>::run(acc, wk, VB, r0, len);
    float* tl = (float*)C.lds;
#pragma unroll
    for (int j = 0; j < 32; ++j) *(f32x2*)(tl + j * D + 2 * tid) = acc[j];
    __syncthreads();
    bf16* A2 = (bf16*)(C.ws + WS_A2);
    const float* cg = P.cn_g + (size_t)l * D; const float* cb = P.cn_b + (size_t)l * D;
#pragma unroll
    for (int jj = 0; jj < 4; ++jj) { const int j = C.wave * 4 + jj; f32x4 v[4]; float s = 0.f;
#pragma unroll
        for (int q = 0; q < 4; ++q) { v[q] = *(const f32x4*)(tl + j * D + 4 * C.lane + 256 * q); s += (v[q][0] + v[q][1]) + (v[q][2] + v[q][3]); }
        const float mu = wave_sum(s) * (1.0f / D); float s2 = 0.f;
#pragma unroll
        for (int q = 0; q < 4; ++q) { v[q] = v[q] - mu; s2 += (v[q][0] * v[q][0] + v[q][1] * v[q][1]) + (v[q][2] * v[q][2] + v[q][3] * v[q][3]); }
        const float rstd = rsqrtf(wave_sum(s2) * (1.0f / D) + EPS);
#pragma unroll
        for (int q = 0; q < 4; ++q) { const int ch = 4 * C.lane + 256 * q; const f32x4 y = v[q] * rstd * *(const f32x4*)(cg + ch) + *(const f32x4*)(cb + ch);
            v2u w; w.x = cvt_pk_bf16(silu_f(y[0]), silu_f(y[1])); w.y = cvt_pk_bf16(silu_f(y[2]), silu_f(y[3]));
            *(v2u*)(A2 + (size_t)(base + r0 + j) * 1536 + 512 + ch) = w; } }
    __syncthreads();
}

__device__ __forceinline__ void rows_final(const Ctx& C0) {
    const Ctx C = mkctx(C0.lds, C0.ws, C0.wv); const Params P = load_params(); (void)P;
    const int gw = C.bid * NWAVES + C.wave, NGW = C.G * NWAVES, lane = C.lane;
    f32x4 gn[4];
#pragma unroll
    for (int j = 0; j < 4; ++j) gn[j] = *(const f32x4*)(P.norm_f_g + 4 * lane + 256 * j);
    for (int row = gw; row < SEQ; row += NGW) { float* xr = P.out + (size_t)row * D; f32x4 v[4]; float ss = 0.f;
#pragma unroll
        for (int j = 0; j < 4; ++j) { v[j] = *(const f32x4*)(xr + 4 * lane + 256 * j); ss += (v[j][0] * v[j][0] + v[j][1] * v[j][1]) + (v[j][2] * v[j][2] + v[j][3] * v[j][3]); }
        const float rstd = rsqrtf(wave_sum(ss) * (1.0f / D) + EPS);
#pragma unroll
        for (int j = 0; j < 4; ++j) *(f32x4*)(xr + 4 * lane + 256 * j) = v[j] * rstd * gn[j]; }
}


template <int K, int LDA, int MODE>
__device__ __forceinline__ void ctx_gemm(int wv, unsigned char* lds, const bf16* A, const bf16* Bt, const bf16* SA, const bf16* SB, bf16* MG, float* XC, const float* gate, const float* gv, bf16* XGo, float* SSo) {
    int t_ = tid_of(wv); asm volatile("" : "+v"(t_));
    const int lane = t_ & 63, wave = wv, r = lane & 15, q = lane >> 4, half = wave >> 2, w4 = wave & 3;
    constexpr int K0 = (MODE == 0) ? 512 : K / 2;
    pg8::f32x4* xch = (pg8::f32x4*)lds;
    for (int t0 = blockIdx.x * 4; t0 < 16 * 64; t0 += gridDim.x * 4) {
        const int task = t0 + w4, ni = task >> 4, mi = task & 15;
        const bf16* ap = A + (size_t)(mi * 16 + r) * LDA + 8 * q; const bf16* bp = Bt + (size_t)(ni * 16 + r) * K + 8 * q;
        pg8::f32x4 acc = {0.f, 0.f, 0.f, 0.f};
        constexpr int NS0 = K0 / 32, NS1 = (K - K0) / 32;
        if (!half) {
#pragma unroll 16
            for (int i = 0; i < NS0; ++i) { const pg8::bf16x8 a = *(const pg8::bf16x8*)(ap + 32 * i), b = *(const pg8::bf16x8*)(bp + 32 * i); acc = __builtin_amdgcn_mfma_f32_16x16x32_bf16(b, a, acc, 0, 0, 0); }
        } else {
#pragma unroll 16
            for (int i = 0; i < NS1; ++i) { const pg8::bf16x8 a = *(const pg8::bf16x8*)(ap + K0 + 32 * i), b = *(const pg8::bf16x8*)(bp + K0 + 32 * i); acc = __builtin_amdgcn_mfma_f32_16x16x32_bf16(b, a, acc, 0, 0, 0); }
        }
        if (half) xch[w4 * 64 + lane] = acc;
        __syncthreads();
        if (!half) {
            const pg8::f32x4 acc2 = xch[w4 * 64 + lane];
            const int row = mi * 16 + r, col = ni * 16 + 4 * q;
            if (MODE == 0) { const size_t off = (size_t)(SEQ + row) * D + col; const v2u a = *(const v2u*)(SA + off), b = *(const v2u*)(SB + off);
                v2u w; w.x = cvt_pk_bf16(bf_lo(a.x) * acc[0] + bf_lo(b.x) * acc2[0], bf_hi(a.x) * acc[1] + bf_hi(b.x) * acc2[1]);
                w.y = cvt_pk_bf16(bf_lo(a.y) * acc[2] + bf_lo(b.y) * acc2[2], bf_hi(a.y) * acc[3] + bf_hi(b.y) * acc2[3]);
                *(v2u*)(MG + off) = w; }
            else { f32x4* p = (f32x4*)(XC + (size_t)row * D + col); const f32x4 g = *(const f32x4*)(gate + col); f32x4 a4 = {acc[0] + acc2[0], acc[1] + acc2[1], acc[2] + acc2[2], acc[3] + acc2[3]}; const f32x4 xv = *p + g * a4; *p = xv;
                const f32x4 y = xv * *(const f32x4*)(gv + col); v2u w; w.x = cvt_pk_bf16(y[0], y[1]); w.y = cvt_pk_bf16(y[2], y[3]); *(v2u*)(XGo + (size_t)(SEQ + row) * D + col) = w;
                float ss = (xv[0] * xv[0] + xv[1] * xv[1]) + (xv[2] * xv[2] + xv[3] * xv[3]); ss += __shfl_xor(ss, 16); ss += __shfl_xor(ss, 32); if (q == 0) atomicAdd(SSo + SEQ + row, ss); }
        }
        __syncthreads();
    }
}

__device__ __forceinline__ void mixer_prep(unsigned char* lds, int wv, int l, int sb, int sG) {
    const Params P = load_params(); unsigned char* ws = P.ws; const Ctx C1 = mkctx(lds, ws, wv); float* scr = (float*)(lds + C1.wave * 16384);
    const float* sh = (const float*)(ws + WS_MOD) + (size_t)l * 2 * NMOD;
    float* cvo = (float*)(ws + WS_CV) + (size_t)l * 2 * NCV;
    for (int it0 = sb * NWAVES + C1.wave; ; it0 += sG * NWAVES) { int it = it0;
        if (transpose_job(it, P.w_in + (size_t)l * D * WIN, D, WIN, (bf16*)(ws + WS_WIN), D, 0, 1, scr, C1.lane, sh, cvo)) continue;
        if (transpose_job(it, P.w_glu + (size_t)l * SSMW * SSMW, SSMW, SSMW, (bf16*)(ws + WS_WGLU), SSMW, 0, 0, scr, C1.lane)) continue;
        if (transpose_job(it, P.w_proj_a + (size_t)l * SSMW * D, SSMW, D, (bf16*)(ws + WS_WPROJ), 1536, 0, 0, scr, C1.lane)) continue;
        if (transpose_job(it, P.w_proj_b + (size_t)l * D * D, D, D, (bf16*)(ws + WS_WPROJ), 1536, 512, 0, scr, C1.lane)) continue;
        if (transpose_job(it, P.w_out + (size_t)l * D * D, D, D, (bf16*)(ws + WS_WOUT), D, 0, 0, scr, C1.lane)) continue;
        break; }
}
__device__ __forceinline__ void ffn_prep(unsigned char* lds, int wv, int l, int sb, int sG) {
    const Params P = load_params(); unsigned char* ws = P.ws; const Ctx C1 = mkctx(lds, ws, wv); float* scr = (float*)(lds + C1.wave * 16384);
    const float* sh = (const float*)(ws + WS_MOD) + (size_t)l * 2 * NMOD + 3 * D;
    float* cvo = (float*)(ws + WS_CV) + (size_t)l * 2 * NCV + WIN;
    for (int it0 = sb * NWAVES + C1.wave; ; it0 += sG * NWAVES) { int it = it0;
        if (transpose_job(it, P.w_gate + (size_t)l * D * FF, D, FF, (bf16*)(ws + WS_WGU), D, 0, 2, scr, C1.lane, sh, cvo)) continue;
        if (transpose_job(it, P.w_up + (size_t)l * D * FF, D, FF, (bf16*)(ws + WS_WGU), D, 0, 3, scr, C1.lane, sh, cvo)) continue;
        if (transpose_job(it, P.w_down + (size_t)l * FF * D, FF, D, (bf16*)(ws + WS_WD), FF, 0, 0, scr, C1.lane)) continue;
        break; }
}

__device__ __forceinline__ void conv_grab(const Ctx& C0, int l, int maxn) {
    unsigned* cnt = (unsigned*)(C0.ws + WS_CTL) + 8192 + 64 * l;
    volatile LAS unsigned* slot = (volatile LAS unsigned*)((LAS unsigned char*)C0.lds + MISC_OFF) + 16;
    for (int n = 0; n < maxn; ++n) {
        if (tid_of(C0.wv) == 0) slot[0] = atomicAdd(cnt, 1u);
        __syncthreads();
        const int tile = (int)slot[0];
        __syncthreads();
        if (tile >= MR / 32) break;
        conv_tile(C0, l, tile);
    }
}

#define GRID_BAR() xcd_barrier(bar)
template <int L>
__device__ __forceinline__ void layer_body(const Ctx& C, unsigned char* lds, PG8_LAS unsigned char* ldsl, int wv, const XcdBarrier& bar) {
        constexpr int l = L; constexpr bool last = (L == 1);
        constexpr int mr = last ? SEQ : MR;
        { unsigned char* ws = load_params().ws; typedef pg8::Cfg<D, D, 16, 1 << 30, -1, 0> CF; pg8::Gemm g{(const bf16*)(ws + WS_XR), (const bf16*)(ws + WS_XR), (const bf16*)(ws + WS_WIN)};
          pg8::StaticOrder S; S.init(MR, WIN, C.G, C.bid);
          EpiWin E{(bf16*)(ws + WS_U), (bf16*)(ws + WS_VB), (bf16*)(ws + WS_SA), (bf16*)(ws + WS_SB), (const float*)(ws + WS_SS) + (size_t)(l * 2) * MR, (const float*)(ws + WS_CV) + (size_t)l * 2 * NCV};
          pg8::gemm_phase<CF>(ldsl, g, S, E, wv); }
        GRID_BAR();
        { unsigned char* ws = load_params().ws; typedef pg8::Cfg<256, 16 * SSMW, SSMW, 1 << 30, -1, 16> CF; pg8::Gemm g{(const bf16*)(ws + WS_U), (const bf16*)(ws + WS_U), (const bf16*)(ws + (l ? WS_BAM1 : WS_BAM))};
          pg8::StaticOrder S; S.init(NCHP, NG * 256, C.G, C.bid);
          EpiS1 E{(float*)(ws + WS_XR)};
          pg8::gemm_phase<CF>(ldsl, g, S, E, wv);
          if (C.bid >= (NCHP / 256) * NG) conv_grab(C, l, 1); }
        GRID_BAR();
        { if (C.G > 64) { if (C.bid < 64) carry_scan(C, l, C.bid); else conv_grab(C, l, 2); }
          else { for (int gd = C.bid; gd < 64; gd += C.G) carry_scan(C, l, gd); conv_grab(C, l, 2); } }
        GRID_BAR();
        { unsigned char* ws = load_params().ws; typedef pg8::Cfg<512, 16 * SSMW, SSMW, 4, -1, 16> CF; pg8::Gemm g{(const bf16*)(ws + WS_U), (const bf16*)(ws + WS_HST), (const bf16*)(ws + (l ? WS_TC1 : WS_TC))};
          pg8::StaticOrder S; S.init(NCHP, NG * 256, C.G, C.bid);
          EpiS3 E{(bf16*)(ws + WS_XR)};
          pg8::gemm_phase<CF>(ldsl, g, S, E, wv);
          if (C.bid >= (NCHP / 256) * NG) conv_grab(C, l, 1 << 20); else if (C.G <= (NCHP / 256) * NG) conv_grab(C, l, 1 << 20); }
        GRID_BAR();
        { unsigned char* ws = load_params().ws; typedef pg8::Cfg<SSMW, SSMW, 16, 1 << 30, -1, 0> CF; pg8::Gemm g{(const bf16*)(ws + WS_XR), (const bf16*)(ws + WS_XR), (const bf16*)(ws + WS_WGLU)};
          pg8::StaticOrder S; S.init(mr, SSMW, C.G, C.bid);
          EpiGlu E{(const bf16*)(ws + WS_XR), (bf16*)(ws + WS_A2)};
          pg8::gemm_phase<CF>(ldsl, g, S, E, wv);
          const int nu = (mr / 256) * 2;
          if (C.G > nu) { if (C.bid >= nu) ffn_prep(lds, wv, l, C.bid - nu, C.G - nu); } else ffn_prep(lds, wv, l, C.bid, C.G); }
        GRID_BAR();
        { unsigned char* ws = load_params().ws; typedef pg8::Cfg<1536, 1536, 16, 1 << 30, 8, 0> CF; pg8::Gemm g{(const bf16*)(ws + WS_A2), (const bf16*)(ws + WS_A2), (const bf16*)(ws + WS_WPROJ)};
          pg8::StaticOrder S; S.init(SEQ, D, C.G, C.bid);
          EpiMerged E{(const bf16*)(ws + WS_SA), (const bf16*)(ws + WS_SB), (bf16*)(ws + WS_VB)};
          pg8::gemm_phase<CF>(ldsl, g, S, E, wv);
          if constexpr (!last) ctx_gemm<1536, 1536, 0>(wv, lds, (const bf16*)(ws + WS_A2) + (size_t)SEQ * 1536, (const bf16*)(ws + WS_WPROJ), (const bf16*)(ws + WS_SA), (const bf16*)(ws + WS_SB), (bf16*)(ws + WS_VB), nullptr, nullptr, nullptr, nullptr, nullptr); }
        GRID_BAR();
        { unsigned char* ws = load_params().ws; typedef pg8::Cfg<D, D, 16, 1 << 30, -1, 0> CF; pg8::Gemm g{(const bf16*)(ws + WS_VB), (const bf16*)(ws + WS_VB), (const bf16*)(ws + WS_WOUT)};
          pg8::StaticOrder S; S.init(SEQ, D, C.G, C.bid);
          const float* modl = (const float*)(ws + WS_MOD) + (size_t)l * 2 * NMOD; const float* gvl = (const float*)(ws + WS_GV) + (size_t)(l * 4 + 1) * D;
          float* ss2 = (float*)(ws + WS_SS) + (size_t)(l * 2 + 1) * MR;
          { EpiRes<true> E{load_params().out, modl + 2 * D, gvl, (bf16*)(ws + WS_XR), ss2, nullptr, nullptr, nullptr}; pg8::gemm_phase<CF>(ldsl, g, S, E, wv); }
          if constexpr (!last) ctx_gemm<D, D, 1>(wv, lds, (const bf16*)(ws + WS_VB) + (size_t)SEQ * D, (const bf16*)(ws + WS_WOUT), nullptr, nullptr, nullptr, (float*)(ws + WS_XC), modl + NMOD + 2 * D, gvl + 2 * D, (bf16*)(ws + WS_XR), ss2); }
        GRID_BAR();
        { unsigned char* ws = load_params().ws; typedef pg8::Cfg<D, D, 16, 1 << 30, -1, 0> CF; pg8::Gemm g{(const bf16*)(ws + WS_XR), (const bf16*)(ws + WS_XR), (const bf16*)(ws + WS_WGU)};
          pg8::StaticOrder S; S.init(mr, 2 * FF, C.G, C.bid);
          EpiFfn E{(bf16*)(ws + WS_HID), (const float*)(ws + WS_SS) + (size_t)(l * 2 + 1) * MR, (const float*)(ws + WS_CV) + (size_t)l * 2 * NCV + WIN};
          pg8::gemm_phase<CF>(ldsl, g, S, E, wv);
          if constexpr (!last) { const int nfull = ((mr / 256) * 22) % C.G;
              if (nfull) { if (C.bid >= nfull) mixer_prep(lds, wv, 1, C.bid - nfull, C.G - nfull); }
              else mixer_prep(lds, wv, 1, C.bid, C.G); } }
        GRID_BAR();
        { unsigned char* ws = load_params().ws; typedef pg8::Cfg<FF, FF, 16, 1 << 30, -1, 0> CF; pg8::Gemm g{(const bf16*)(ws + WS_HID), (const bf16*)(ws + WS_HID), (const bf16*)(ws + WS_WD)};
          pg8::StaticOrder S; S.init(SEQ, D, C.G, C.bid);
          const float* modl = (const float*)(ws + WS_MOD) + (size_t)l * 2 * NMOD;
          if constexpr (last) { EpiRes<false> E{load_params().out, modl + 5 * D, nullptr, nullptr, nullptr, nullptr, nullptr, nullptr}; pg8::gemm_phase<CF>(ldsl, g, S, E, wv); }
          else { const float* gvn = (const float*)(ws + WS_GV) + (size_t)(4 + 0) * D;
              float* ss1 = (float*)(ws + WS_SS) + (size_t)2 * MR;
              EpiRes<true> E{load_params().out, modl + 5 * D, gvn, (bf16*)(ws + WS_XR), ss1, nullptr, nullptr, nullptr};
              pg8::gemm_phase<CF>(ldsl, g, S, E, wv);
              ctx_gemm<FF, FF, 1>(wv, lds, (const bf16*)(ws + WS_HID) + (size_t)SEQ * FF, (const bf16*)(ws + WS_WD), nullptr, nullptr, nullptr, (float*)(ws + WS_XC), modl + NMOD + 5 * D, gvn + 2 * D, (bf16*)(ws + WS_XR), ss1); } }
        GRID_BAR();
}

__global__ void __launch_bounds__(NT, 2) fwd_megakernel(Params Pk) {
    extern __shared__ __attribute__((aligned(16))) unsigned char lds[];
    const int wv = __builtin_amdgcn_readfirstlane((int)threadIdx.x >> 6);
    Ctx C; C.tid = tid_of(wv); C.lane = C.tid & 63; C.wave = wv; C.wv = wv; C.G = gridDim.x; C.bid = blockIdx.x; C.lds = lds; C.ws = Pk.ws;
    PG8_LAS unsigned char* ldsl = (PG8_LAS unsigned char*)lds;
    volatile LAS unsigned* MISC = (volatile LAS unsigned*)(ldsl + MISC_OFF);
    for (int u = C.tid; u < (LDS_BYTES - 131072) / 4; u += NT) ((LAS unsigned*)(ldsl + 131072))[u] = 0u;
    __syncthreads();
    XcdBarrier bar = xcd_barrier_post((unsigned*)(Pk.ws + WS_CTL), MISC + 8, wv);

    phase_setup(C);
    GRID_BAR();
    rows_first(C);
    mixer_prep(lds, wv, 0, C.bid, C.G);
    build_s5_mats(C, 0, C.bid, C.G);
    build_s5_mats(C, 1, C.bid, C.G);
    GRID_BAR();

    layer_body<0>(C, lds, ldsl, wv, bar);
    layer_body<1>(C, lds, ldsl, wv, bar);
    rows_final(C);
}

extern "C" void kernel_launch(void* const* d_in, const int* in_sizes, int n_in, void* d_out, int out_size, void* d_ws, size_t ws_size, hipStream_t stream) {
    static int grid = 0;
    if (grid == 0) {
        if (n_in != 29 || out_size != SEQ * D || ws_size < WS_END) { fprintf(stderr, "kernel_launch: unexpected shapes (n_in %d out %d ws %zu)\n", n_in, out_size, ws_size); grid = -1; return; }
        int dev = 0, cus = 0, per_cu = 0;
        if (hipGetDevice(&dev) != hipSuccess || hipDeviceGetAttribute(&cus, hipDeviceAttributeMultiprocessorCount, dev) != hipSuccess) { grid = -1; return; }
        if (hipFuncSetAttribute((const void*)fwd_megakernel, hipFuncAttributeMaxDynamicSharedMemorySize, LDS_BYTES) != hipSuccess) { fprintf(stderr, "kernel_launch: hipFuncSetAttribute failed\n"); grid = -1; return; }
        if (hipOccupancyMaxActiveBlocksPerMultiprocessor(&per_cu, (const void*)fwd_megakernel, NT, LDS_BYTES) != hipSuccess || per_cu < 1) { fprintf(stderr, "kernel_launch: occupancy query says %d\n", per_cu); per_cu = 1; }
        (void)hipGetLastError();
        grid = cus;
    }
    if (grid < 0) return;
    (void)hipMemsetAsync((char*)d_ws + WS_CTL, 0, 64 * 1024, stream);
    Params p{};
    const float** pp = (const float**)&p;
    for (int i = 0; i < 29; ++i) pp[i] = (const float*)d_in[i];
    p.out = (float*)d_out; p.ws = (unsigned char*)d_ws;
    hipLaunchKernelGGL(fwd_megakernel, dim3(grid), dim3(NT), LDS_BYTES, stream, p);
}
```

```cpp
#include <hip/hip_runtime.h>
#include <cstdio>
#include <cstdint>

namespace pg8 {
#define PG8_LAS __attribute__((address_space(3)))
typedef unsigned short bf16_t;
typedef short bf16x8 __attribute__((ext_vector_type(8)));
typedef float f32x4 __attribute__((ext_vector_type(4)));
typedef unsigned u32x4 __attribute__((ext_vector_type(4)));
constexpr int BM = 256, BK = 64, HALF = 128, HTB = HALF * BK * 2, STAGE_BYTES = 8 * HTB, NXCD = 8, WGM = 8;

__host__ __device__ __forceinline__ int lds_byte(int r, int c) { const int st = (r >> 4) * 2 + (c >> 5), rr = r & 15, cc = c & 31, ob = rr * 64 + cc * 2; return st * 1024 + (ob ^ (((ob >> 9) & 1) << 5)); }
__host__ __device__ __forceinline__ void stage_rc(int b, int& R, int& C) { const int st = b / 1024, sb = b % 1024, swz = sb ^ (((sb >> 9) & 1) << 5); R = (st >> 1) * 16 + swz / 64; C = (st & 1) * 32 + (swz % 64) / 2; }
__host__ __device__ __forceinline__ int perm32(int rho) { const int n = rho >> 4, i = rho & 15; return 8 * (i >> 2) + 4 * n + (i & 3); }

struct Unit { int pm, pn; };
struct Gemm { const bf16_t* A; const bf16_t* A2; const bf16_t* Bt; };
template <int K_, int LDA_, int JS_, int TSPLIT_, int TMID_, int APN_> struct Cfg { static constexpr int K = K_, lda = LDA_, jstride = JS_, tsplit = TSPLIT_, tmid = TMID_, apn = APN_; };

struct StaticOrder {
    int nM, nN, nwg, G, c;
    __host__ __device__ void init(int M, int N, int G_, int c_) { nM = M / BM; nN = N / BM; nwg = nM * nN; G = G_; c = c_; }
    __host__ __device__ bool next(int i, Unit& u) const {
        const long L = (long)i * G + c; if (L >= nwg) return false;
        int wgid = (int)L; { const int q = nwg / NXCD, r = nwg % NXCD, xcd = wgid % NXCD, off = wgid / NXCD; wgid = (xcd < r ? xcd * (q + 1) : r * (q + 1) + (xcd - r) * q) + off; }
        const int nig = WGM * nN, gid = wgid / nig, fm = gid * WGM, gsz = (nM - fm) < WGM ? (nM - fm) : WGM;
        u.pm = fm + ((wgid % nig) % gsz); u.pn = (wgid % nig) / gsz; return true;
    }
};

__device__ __forceinline__ unsigned cvt_pk_bf16(float lo, float hi) { unsigned r; asm volatile("v_cvt_pk_bf16_f32 %0, %1, %2" : "=v"(r) : "v"(lo), "v"(hi)); return r; }

template <class CF, class Epi, class Sched>
__device__ __forceinline__ void gemm_phase(PG8_LAS unsigned char* lds, const Gemm g, const Sched& S, const Epi& E, int wv) {
    int tid_; asm volatile("v_mbcnt_lo_u32_b32 %0, -1, 0\n\tv_mbcnt_hi_u32_b32 %0, -1, %0" : "=v"(tid_)); tid_ += wv * 64; asm volatile("" : "+v"(tid_));
    const int tid = tid_, wid = __builtin_amdgcn_readfirstlane(tid >> 6), lane = tid & 63, wr = wid >> 2, wc = wid & 3, fr = lane & 15, fq = lane >> 4;
    constexpr int K = CF::K, nt = K / BK, tsplit = CF::tsplit;
    unsigned voffA[2], voffB[2];
#pragma unroll
    for (int i = 0; i < 2; ++i) { int R, C; stage_rc(tid * 16 + i * 8192, R, C); const int Rb = Epi::PERM ? ((R & ~31) + perm32(R & 31)) : R;
        voffA[i] = (unsigned)(R * CF::lda + (C >> 4) * CF::jstride + (C & 15)) * 2u; voffB[i] = (unsigned)(Rb * K + C) * 2u; }
    constexpr size_t kstepA = (size_t)CF::jstride * 8, kstepB = (size_t)(BK * 2);
    constexpr size_t hstepA = (size_t)HALF * CF::lda * 2, hstepB = (size_t)HALF * K * 2;
    constexpr size_t tstepA = 2 * hstepA, tstepB = 2 * hstepB, apnb = (size_t)CF::apn * 2;
    const unsigned ldsw = (unsigned)wid * 1024u;
    const int aoff = lds_byte(wr * 64 + fr, fq * 8), boff = lds_byte(wc * 32 + fr, fq * 8);
#define PG8_SA(b, h) (((b) * 2 + (h)) * HTB)
#define PG8_SB(b, h) ((4 + (b) * 2 + (h)) * HTB)
#define PG8_STAGE(bufoff, gbase, voff) do { _Pragma("unroll") for (int _i = 0; _i < 2; ++_i) \
        __builtin_amdgcn_global_load_lds((const unsigned*)((const char*)(gbase) + (voff)[_i]), (PG8_LAS unsigned*)(lds + (bufoff) + ldsw + _i * 8192), 16, 0, 0); } while (0)
#define PG8_LDA(dst, b, h) do { _Pragma("unroll") for (int m = 0; m < 4; ++m) _Pragma("unroll") for (int k = 0; k < 2; ++k) dst[m][k] = *(const PG8_LAS bf16x8*)(lds + PG8_SA(b, h) + aoff + m * 2048 + k * 1024); } while (0)
#define PG8_LDB(dst, b, h) do { _Pragma("unroll") for (int n = 0; n < 2; ++n) _Pragma("unroll") for (int k = 0; k < 2; ++k) dst[n][k] = *(const PG8_LAS bf16x8*)(lds + PG8_SB(b, h) + boff + n * 2048 + k * 1024); } while (0)
#define PG8_MMA(ai, bj, At, Bt) do { __builtin_amdgcn_s_setprio(1); _Pragma("unroll") for (int m = 0; m < 4; ++m) _Pragma("unroll") for (int n = 0; n < 2; ++n) _Pragma("unroll") for (int k = 0; k < 2; ++k) \
        acc[ai][bj][m][n] = __builtin_amdgcn_mfma_f32_16x16x32_bf16(Bt[n][k], At[m][k], acc[ai][bj][m][n], 0, 0, 0); __builtin_amdgcn_s_setprio(0); } while (0)
#define PG8_WAIT_V(n) asm volatile("s_waitcnt vmcnt(" #n ")" ::: "memory")
#define PG8_WAIT_L(n) asm volatile("s_waitcnt lgkmcnt(" #n ")" ::: "memory")
#define PG8_BAR __builtin_amdgcn_s_barrier()
#define PG8_SCHED __builtin_amdgcn_sched_barrier(0)
#define PG8_UA(u)  ((const char*)g.A  + (size_t)(u).pm * tstepA + (size_t)(u).pn * apnb)
#define PG8_UA2(u) ((const char*)g.A2 + (size_t)(u).pm * tstepA + (size_t)(u).pn * apnb - (size_t)tsplit * kstepA)
    Unit cur, nxt; int ui = 0;
    if (!S.next(0, cur)) return;
    f32x4 acc[2][2][4][2];
#pragma unroll
    for (int a = 0; a < 2; ++a)
#pragma unroll
        for (int b = 0; b < 2; ++b)
#pragma unroll
            for (int m = 0; m < 4; ++m)
#pragma unroll
                for (int n = 0; n < 2; ++n) acc[a][b][m][n] = (f32x4){0.f, 0.f, 0.f, 0.f};
    bf16x8 At[4][2], B0[2][2], B1[2][2];
    const char* cA = PG8_UA(cur); const char* cA2 = PG8_UA2(cur); const char* cB = (const char*)g.Bt + (size_t)cur.pn * tstepB;
    PG8_STAGE(PG8_SB(0, 0), cB, voffB); PG8_STAGE(PG8_SB(0, 1), cB + hstepB, voffB); PG8_STAGE(PG8_SA(0, 0), cA, voffA); PG8_STAGE(PG8_SA(0, 1), cA + hstepA, voffA);
    if (wr == 1) PG8_BAR;
    PG8_WAIT_V(2); PG8_BAR;
    PG8_STAGE(PG8_SB(1, 0), cB + kstepB, voffB); PG8_STAGE(PG8_SA(1, 0), cA + kstepA, voffA); PG8_STAGE(PG8_SB(1, 1), cB + hstepB + kstepB, voffB);
    PG8_WAIT_V(6); PG8_BAR;
    for (;;) {
        const bool has_next = S.next(ui + 1, nxt);
        const char* nA = has_next ? PG8_UA(nxt) : cA; const char* nB = has_next ? (const char*)g.Bt + (size_t)nxt.pn * tstepB : cB;
        for (int t = 0; t < nt; t += 2) {
            if constexpr (Epi::MID) { if (t == CF::tmid) E.mid(acc, cur, wr, wc, fr, fq); }
            const bool last = (t == nt - 2);
            const char* a1 = ((t + 1 < tsplit) ? cA : cA2) + (size_t)(t + 1) * kstepA;
            const char* a2 = last ? nA : ((t + 2 < tsplit) ? cA : cA2) + (size_t)(t + 2) * kstepA;
            const char* b2 = last ? nB : cB + (size_t)(t + 2) * kstepB;
            const char* a3 = a2 + kstepA; const char* b3 = b2 + kstepB;
            PG8_LDB(B0, 0, 0); PG8_LDB(B1, 0, 1); PG8_SCHED; PG8_LDA(At, 0, 0); PG8_STAGE(PG8_SA(1, 1), a1 + hstepA, voffA);
            PG8_WAIT_V(8); PG8_WAIT_L(0); PG8_BAR; PG8_MMA(0, 0, At, B0); PG8_MMA(0, 1, At, B1); PG8_BAR; PG8_SCHED;
            PG8_LDA(At, 0, 1); PG8_STAGE(PG8_SB(0, 0), b2, voffB); PG8_STAGE(PG8_SB(0, 1), b2 + hstepB, voffB); PG8_STAGE(PG8_SA(0, 0), a2, voffA);
            PG8_WAIT_V(8); PG8_WAIT_L(0); PG8_BAR; PG8_MMA(1, 0, At, B0); PG8_MMA(1, 1, At, B1); PG8_BAR; PG8_SCHED;
            PG8_LDB(B0, 1, 0); PG8_LDB(B1, 1, 1); PG8_SCHED; PG8_LDA(At, 1, 0); PG8_STAGE(PG8_SA(0, 1), a2 + hstepA, voffA);
            PG8_WAIT_V(8); PG8_WAIT_L(0); PG8_BAR; PG8_MMA(0, 0, At, B0); PG8_MMA(0, 1, At, B1); PG8_BAR; PG8_SCHED;
            PG8_LDA(At, 1, 1); PG8_STAGE(PG8_SB(1, 0), b3, voffB); PG8_STAGE(PG8_SB(1, 1), b3 + hstepB, voffB); PG8_STAGE(PG8_SA(1, 0), a3, voffA);
            PG8_WAIT_V(8); PG8_WAIT_L(0); PG8_BAR; PG8_MMA(1, 0, At, B0); PG8_MMA(1, 1, At, B1); PG8_BAR; PG8_SCHED;
        }
        if (wr == 0) PG8_BAR;
        E(acc, cur, wr, wc, fr, fq);
        if (!has_next) break;
#pragma unroll
        for (int a = 0; a < 2; ++a)
#pragma unroll
            for (int b = 0; b < 2; ++b)
#pragma unroll
                for (int m = 0; m < 4; ++m)
#pragma unroll
                    for (int n = 0; n < 2; ++n) acc[a][b][m][n] = (f32x4){0.f, 0.f, 0.f, 0.f};
        cur = nxt; cA = nA; cA2 = PG8_UA2(cur); cB = nB; ++ui;
        if (wr == 1) PG8_BAR;
    }
    PG8_WAIT_V(0);
    PG8_BAR;
#undef PG8_SA
#undef PG8_SB
#undef PG8_STAGE
#undef PG8_LDA
#undef PG8_LDB
#undef PG8_MMA
#undef PG8_WAIT_V
#undef PG8_WAIT_L
#undef PG8_BAR
#undef PG8_SCHED
#undef PG8_UA
#undef PG8_UA2
}
}

constexpr int NWAVES = 8, NT = NWAVES * 64;
constexpr int D = 1024, SEQ = 16384, CTXN = 256, MR = SEQ + CTXN  ;
constexpr int SSMW = 512, NG = 32, NP = 64, FF = 2816, WIN = 4608, NMOD = 6 * D;
constexpr int NCH = MR / 16  , NCHP = 1280  ;
constexpr float EPS = 1e-6f;
constexpr size_t MiB = 1u << 20;
constexpr size_t WS_CTL = 0;
constexpr size_t WS_MOD = 64 * 1024;
constexpr size_t WS_A16 = 192 * 1024;
constexpr size_t WS_POSR = 256 * 1024, WS_POSC = 768 * 1024 + 0;
constexpr size_t WS_XC = 1 * MiB;
constexpr size_t WS_APOW = 2 * MiB;
constexpr size_t WS_BTC = 3 * MiB + 256 * 1024;
constexpr size_t WS_SS = 4 * MiB + 512 * 1024;
constexpr size_t WS_CV = 5 * MiB;
constexpr size_t WS_GV = 5 * MiB + 512 * 1024;
constexpr int NCV = WIN + 2 * FF;
constexpr size_t WS_WIN = 6 * MiB, WS_WGLU = 15 * MiB, WS_WPROJ = 15 * MiB + 512 * 1024, WS_WOUT = 18 * MiB + 512 * 1024;
constexpr size_t WS_BAM = 20 * MiB + 512 * 1024, WS_TC = 24 * MiB + 512 * 1024;
constexpr size_t WS_XR = 32 * MiB + 512 * 1024;
constexpr size_t WS_U = 65 * MiB, WS_HST = 81 * MiB + 256 * 1024;
constexpr size_t WS_WGU = 65 * MiB, WS_WD = 76 * MiB;
constexpr size_t WS_VB = 97 * MiB + 512 * 1024;
constexpr size_t WS_SA = 130 * MiB, WS_SB = 162 * MiB + 512 * 1024;
constexpr size_t WS_A2 = 195 * MiB;
constexpr size_t WS_HID = WS_VB;
constexpr size_t WS_BAM1 = 244 * MiB, WS_TC1 = 248 * MiB;
constexpr size_t WS_END = 256 * MiB;
static_assert(WS_HID + (size_t)MR * FF * 2 <= WS_A2, "hid overlay");
static_assert(WS_A2 + (size_t)MR * 1536 * 2 <= WS_END, "a2");
static_assert(WS_WD + (size_t)D * FF * 2 <= WS_VB, "wd");
static_assert(WS_BTC + 8192 * 32 * 4 <= WS_WIN && WS_APOW + 8192 * 34 * 4 <= WS_BTC, "small");

constexpr int LDS_BYTES = 147456, MISC_OFF = 131072 + 320;

#define LAS __attribute__((address_space(3)))
__device__ __forceinline__ int lane_id_v() { int l; asm volatile("v_mbcnt_lo_u32_b32 %0, -1, 0\n\tv_mbcnt_hi_u32_b32 %0, -1, %0" : "=v"(l)); return l; }
__device__ __forceinline__ int tid_of(int wv) { return wv * 64 + lane_id_v(); }
typedef unsigned short bf16;
typedef unsigned v4u __attribute__((ext_vector_type(4)));
typedef unsigned v2u __attribute__((ext_vector_type(2)));
typedef float f32x4 __attribute__((ext_vector_type(4)));
typedef float f32x2 __attribute__((ext_vector_type(2)));
using pg8::cvt_pk_bf16;

__device__ __forceinline__ float bf_lo(unsigned u) { return __uint_as_float(u << 16); }
__device__ __forceinline__ float bf_hi(unsigned u) { return __uint_as_float(u & 0xffff0000u); }
__device__ __forceinline__ unsigned f2bf(float f) { unsigned u = __float_as_uint(f); return (u + 0x7fffu + ((u >> 16) & 1u)) >> 16; }
__device__ __forceinline__ float sigm(float x) { return __builtin_amdgcn_rcpf(1.0f + __expf(-x)); }
__device__ __forceinline__ float silu_f(float x) { return x * sigm(x); }
__device__ __forceinline__ float gelu_tanh(float x) { return x * sigm(1.5957691216057308f * (x + 0.044715f * x * x * x)); }
__device__ __forceinline__ float wave_sum(float v) {
#pragma unroll
    for (int o = 1; o < 64; o <<= 1) v += __shfl_xor(v, o);
    return v;
}
__device__ __forceinline__ void sincos_cw(float x, float& s, float& c) {
    const float kf = rintf(x * 0.63661977236758134f);
    float r = fmaf(-kf, 1.5703125f, x); r = fmaf(-kf, 4.837512969970703125e-4f, r); r = fmaf(-kf, 7.54978995489188216e-8f, r);
    const float r2 = r * r;
    float sp = fmaf(r2, 2.7557319e-6f, -1.9841270e-4f); sp = fmaf(sp, r2, 8.3333333e-3f); sp = fmaf(sp, r2, -1.6666667e-1f); sp = fmaf(sp * r2, r, r);
    float cp = fmaf(r2, -2.7557319e-7f, 2.4801587e-5f); cp = fmaf(cp, r2, -1.3888889e-3f); cp = fmaf(cp, r2, 4.1666667e-2f); cp = fmaf(cp, r2, -0.5f); cp = fmaf(cp, r2, 1.0f);
    const int q = ((int)kf) & 3;
    const float ss = (q & 1) ? cp : sp, cc = (q & 1) ? sp : cp;
    s = (q & 2) ? -ss : ss; c = ((q + 1) & 2) ? -cc : cc;
}

struct Params {
    const float *x, *c, *ctx, *c_ctx, *w_mod, *b_mod, *norm1_g, *norm2_g, *w_in, *lam_re, *lam_im, *log_step, *b_re, *b_im, *c_re, *c_im, *ssm_d,
        *w_glu, *w_proj_a, *dw_kernel, *dw_bias, *cn_g, *cn_b, *w_proj_b, *w_out, *w_gate, *w_up, *w_down, *norm_f_g;
    float* out; unsigned char* ws;
};
__device__ __forceinline__ Params load_params() {
    Params p{};
#if defined(__HIP_DEVICE_COMPILE__)
    typedef const void* cvp;
    const __attribute__((address_space(4))) cvp* kp = (const __attribute__((address_space(4))) cvp*)__builtin_amdgcn_kernarg_segment_ptr(); asm volatile("" : "+s"(kp));
    cvp* dst = (cvp*)&p;
#pragma unroll
    for (int i = 0; i < 31; ++i) dst[i] = kp[i];
#endif
    return p;
}

#define XB_TMO      128
#define XB_XCNT(j)  (256  + 64 * (j))
#define XB_XSUB(j)  (1280 + 64 * (j))
#define XB_XGEN(j)  (2304 + 64 * (j))
#define XB_TOP      3328
#define XB_TOPGEN   3392
#define XCD_BAR_WORDS 3456
#define XB_SPIN_CAP (1u << 18)
__device__ __forceinline__ unsigned xb_ld(unsigned* p)              { return __hip_atomic_load(p, __ATOMIC_RELAXED, __HIP_MEMORY_SCOPE_AGENT); }
__device__ __forceinline__ unsigned xb_add(unsigned* p, unsigned v) { return __hip_atomic_fetch_add(p, v, __ATOMIC_RELAXED, __HIP_MEMORY_SCOPE_AGENT); }
__device__ __forceinline__ unsigned xb_xcc_id() { return (unsigned)__builtin_amdgcn_s_getreg((3 << 11) | 20) & 0xFu; }
#define XB_SPIN(cond, bar) do { unsigned _sp = 0; while (cond) { __builtin_amdgcn_s_sleep(1); \
    if ((++_sp & 255u) == 0u) { if (xb_ld(&(bar)[XB_TMO])) break; if (_sp > XB_SPIN_CAP) { atomicAdd(&(bar)[XB_TMO], 1u); break; } } } } while (0)
struct XcdBarrier { unsigned* bar; unsigned x; volatile LAS unsigned* st; int wv; };
__device__ __forceinline__ XcdBarrier xcd_barrier_post(unsigned* bar, volatile LAS unsigned* st, int wv) {
    XcdBarrier b; b.bar = bar; b.x = xb_xcc_id(); b.st = st; b.wv = wv;
    if (tid_of(wv) == 0) (void)xb_add(&bar[XB_XCNT(b.x)], 1u);
    return b;
}
__device__ __forceinline__ void xcd_barrier_complete(unsigned* bar, unsigned x, unsigned& nloc, unsigned& nx) {
    const unsigned G = gridDim.x * gridDim.y * gridDim.z;
    unsigned sum, cnt, mine, sp = 0u;
    for (;;) {
        sum = 0u; cnt = 0u; mine = 0u;
#pragma unroll
        for (unsigned j = 0; j < 16; ++j) { const unsigned c = xb_ld(&bar[XB_XCNT(j)]); sum += c; cnt += (c > 0u) ? 1u : 0u; mine = (j == x) ? c : mine; }
        if (sum == G) break;
        __builtin_amdgcn_s_sleep(1);
        if ((++sp & 255u) == 0u) { if (xb_ld(&bar[XB_TMO])) break; if (sp > XB_SPIN_CAP) { atomicAdd(&bar[XB_TMO], 1u); break; } }
    }
    nloc = mine > 0u ? mine : 1u; nx = cnt > 0u ? cnt : 1u;
}
__device__ __forceinline__ void xcd_barrier(const XcdBarrier& b0) {
    asm volatile("s_waitcnt vmcnt(0)" ::: "memory");
    __syncthreads();
    if (tid_of(b0.wv) == 0) {
        XcdBarrier b; b.bar = (unsigned*)(load_params().ws + WS_CTL); b.x = xb_xcc_id(); b.st = b0.st;
        unsigned* bar = b.bar;
        __builtin_amdgcn_s_waitcnt(0);
        unsigned nloc = b.st[0], nx = b.st[1];
        if (nloc == 0u) { xcd_barrier_complete(bar, b.x, nloc, nx); b.st[0] = nloc; b.st[1] = nx; }
        const unsigned old = xb_add(&bar[XB_XSUB(b.x)], 1u);
        const unsigned gen = old / nloc;
        if (old + 1u == (gen + 1u) * nloc) {
            __builtin_amdgcn_fence(__ATOMIC_RELEASE, "agent");
            asm volatile("s_waitcnt vmcnt(0)" ::: "memory");
            const unsigned og = xb_add(&bar[XB_TOP], 1u);
            const unsigned tg = og / nx;
            if (og + 1u == (tg + 1u) * nx) xb_add(&bar[XB_TOPGEN], 1u);
            else XB_SPIN(xb_ld(&bar[XB_TOPGEN]) == tg, bar);
            __builtin_amdgcn_fence(__ATOMIC_ACQUIRE, "agent");
            xb_add(&bar[XB_XGEN(b.x)], 1u);
            asm volatile("s_waitcnt vmcnt(0)" ::: "memory");
        } else {
            XB_SPIN(xb_ld(&bar[XB_XGEN(b.x)]) == gen, bar);
            __builtin_amdgcn_fence(__ATOMIC_ACQUIRE, "agent");
            asm volatile("s_waitcnt vmcnt(0)" ::: "memory");
        }
    }
    __syncthreads();
}

typedef pg8::f32x4 (AccT)[2][2][4][2];
#define FOR_AI_M _Pragma("unroll") for (int ai = 0; ai < 2; ++ai) _Pragma("unroll") for (int m = 0; m < 4; ++m)

struct EpiWin {
    static constexpr bool PERM = true, MID = false;
    bf16 *U, *VB, *SA, *SB; const float* SS; const float* CV;
    __device__ __forceinline__ void operator()(const AccT& acc, const pg8::Unit& u, int wr, int wc, int fr, int fq) const {
        const int row0 = u.pm * 256 + wr * 64 + fr, cl = wc * 32 + 8 * fq;
        const float* cv = CV + (u.pm >= 64 ? NCV : 0) + u.pn * 256 + cl;
        f32x4 c00 = *(const f32x4*)(cv), c01 = *(const f32x4*)(cv + 4), c10 = *(const f32x4*)(cv + 128), c11 = *(const f32x4*)(cv + 132);
        float rsv[2][4];
        FOR_AI_M rsv[ai][m] = SS[row0 + ai * 128 + m * 16];
        FOR_AI_M rsv[ai][m] = rsqrtf(rsv[ai][m] * (1.0f / D) + EPS);
        if (u.pn >= 2 && u.pn < 10) {
            FOR_AI_M { const int row = row0 + ai * 128 + m * 16; const float rs = rsv[ai][m];
                const f32x4 v0 = acc[ai][0][m][0] * rs + c00, v1 = acc[ai][0][m][1] * rs + c01, g0 = acc[ai][1][m][0] * rs + c10, g1 = acc[ai][1][m][1] * rs + c11;
                v4u w; w.x = cvt_pk_bf16(v0[0] * sigm(g0[0]), v0[1] * sigm(g0[1])); w.y = cvt_pk_bf16(v0[2] * sigm(g0[2]), v0[3] * sigm(g0[3]));
                w.z = cvt_pk_bf16(v1[0] * sigm(g1[0]), v1[1] * sigm(g1[1])); w.w = cvt_pk_bf16(v1[2] * sigm(g1[2]), v1[3] * sigm(g1[3]));
                *(v4u*)(VB + (size_t)row * 1024 + (u.pn - 2) * 128 + cl) = w; }
        } else {
            bf16* base; int ldc, colt; bool sg;
            if (u.pn < 2) { base = U; ldc = 512; colt = u.pn * 256; sg = false; }
            else if (u.pn < 14) { base = SA; ldc = 1024; colt = (u.pn - 10) * 256; sg = true; }
            else { base = SB; ldc = 1024; colt = (u.pn - 14) * 256; sg = true; }
            FOR_AI_M { const int row = row0 + ai * 128 + m * 16; const float rs = rsv[ai][m];
#pragma unroll
                for (int bj = 0; bj < 2; ++bj) { f32x4 v0 = acc[ai][bj][m][0] * rs + (bj ? c10 : c00), v1 = acc[ai][bj][m][1] * rs + (bj ? c11 : c01);
                    if (sg) { for (int i = 0; i < 4; ++i) { v0[i] = sigm(v0[i]); v1[i] = sigm(v1[i]); } }
                    v4u w; w.x = cvt_pk_bf16(v0[0], v0[1]); w.y = cvt_pk_bf16(v0[2], v0[3]); w.z = cvt_pk_bf16(v1[0], v1[1]); w.w = cvt_pk_bf16(v1[2], v1[3]);
                    *(v4u*)(base + (size_t)row * ldc + colt + bj * 128 + cl) = w; } }
        }
    }
};
struct EpiS1 {
    static constexpr bool PERM = false, MID = false;
    float* S;
    __device__ __forceinline__ void operator()(const AccT& acc, const pg8::Unit& u, int wr, int wc, int fr, int fq) const {
        float* sp = S + (size_t)(u.pm * 256 + wr * 64 + fr) * 8192 + u.pn * 256 + wc * 32 + 4 * fq;
        if (u.pm < 4) {
            FOR_AI_M {
#pragma unroll
                for (int bj = 0; bj < 2; ++bj)
#pragma unroll
                    for (int n = 0; n < 2; ++n) *(f32x4*)(sp + (size_t)(ai * 128 + m * 16) * 8192 + bj * 128 + n * 16) = acc[ai][bj][m][n]; asm volatile("" ::: "memory"); }
        } else if (wr == 0) {
#pragma unroll
            for (int bj = 0; bj < 2; ++bj)
#pragma unroll
                for (int n = 0; n < 2; ++n) *(f32x4*)(sp + bj * 128 + n * 16) = acc[0][bj][0][n];
        }
    }
};
struct EpiS3 {
    static constexpr bool PERM = true, MID = false;
    bf16* YA;
    __device__ __forceinline__ void operator()(const AccT& acc, const pg8::Unit& u, int wr, int wc, int fr, int fq) const {
        const int row0 = u.pm * 256 + wr * 64 + fr;
        FOR_AI_M { const int chunk = row0 + ai * 128 + m * 16;
#pragma unroll
            for (int bj = 0; bj < 2; ++bj) { const int col8 = bj * 128 + wc * 32 + 8 * fq, t = col8 >> 4, ch = u.pn * 16 + (col8 & 15);
                const f32x4 a0 = acc[ai][bj][m][0], a1 = acc[ai][bj][m][1];
                v4u w; w.x = cvt_pk_bf16(gelu_tanh(a0[0]), gelu_tanh(a0[1])); w.y = cvt_pk_bf16(gelu_tanh(a0[2]), gelu_tanh(a0[3]));
                w.z = cvt_pk_bf16(gelu_tanh(a1[0]), gelu_tanh(a1[1])); w.w = cvt_pk_bf16(gelu_tanh(a1[2]), gelu_tanh(a1[3]));
                *(v4u*)(YA + (size_t)(chunk * 16 + t) * 512 + ch) = w; } asm volatile("" ::: "memory"); }
    }
};
struct EpiGlu {
    static constexpr bool PERM = true, MID = false;
    const bf16* YA; bf16* A2;
    __device__ __forceinline__ void operator()(const AccT& acc, const pg8::Unit& u, int wr, int wc, int fr, int fq) const {
        const int row0 = u.pm * 256 + wr * 64 + fr, col0 = u.pn * 256 + wc * 32 + 8 * fq;
        v4u yv[2][4][2];
        FOR_AI_M { const int row = row0 + ai * 128 + m * 16;
#pragma unroll
            for (int bj = 0; bj < 2; ++bj) yv[ai][m][bj] = *(const v4u*)(YA + (size_t)row * 512 + col0 + bj * 128); }
        FOR_AI_M { const int row = row0 + ai * 128 + m * 16;
#pragma unroll
            for (int bj = 0; bj < 2; ++bj) { const int col = col0 + bj * 128; const v4u y = yv[ai][m][bj]; const f32x4 a0 = acc[ai][bj][m][0], a1 = acc[ai][bj][m][1];
                v4u w; w.x = cvt_pk_bf16(bf_lo(y.x) * sigm(a0[0]), bf_hi(y.x) * sigm(a0[1])); w.y = cvt_pk_bf16(bf_lo(y.y) * sigm(a0[2]), bf_hi(y.y) * sigm(a0[3]));
                w.z = cvt_pk_bf16(bf_lo(y.z) * sigm(a1[0]), bf_hi(y.z) * sigm(a1[1])); w.w = cvt_pk_bf16(bf_lo(y.w) * sigm(a1[2]), bf_hi(y.w) * sigm(a1[3]));
                *(v4u*)(A2 + (size_t)row * 1536 + col) = w; } }
    }
};
struct EpiMerged {
    static constexpr bool PERM = true, MID = true;
    const bf16 *SA, *SB; bf16* MG;
    __device__ __forceinline__ void mid(AccT& acc, const pg8::Unit& u, int wr, int wc, int fr_, int fq_) const {
        int fr = fr_, fq = fq_; asm volatile("" : "+v"(fr), "+v"(fq));
        const int row0 = u.pm * 256 + wr * 64 + fr, col0 = u.pn * 256 + wc * 32 + 8 * fq;
        FOR_AI_M { const int row = row0 + ai * 128 + m * 16;
#pragma unroll
            for (int bj = 0; bj < 2; ++bj) { const size_t off = (size_t)row * 1024 + col0 + bj * 128; const v4u a = *(const v4u*)(SA + off), b = *(const v4u*)(SB + off);
                f32x4& a0 = acc[ai][bj][m][0]; f32x4& a1 = acc[ai][bj][m][1];
                a0[0] *= bf_lo(a.x) * __builtin_amdgcn_rcpf(bf_lo(b.x)); a0[1] *= bf_hi(a.x) * __builtin_amdgcn_rcpf(bf_hi(b.x));
                a0[2] *= bf_lo(a.y) * __builtin_amdgcn_rcpf(bf_lo(b.y)); a0[3] *= bf_hi(a.y) * __builtin_amdgcn_rcpf(bf_hi(b.y));
                a1[0] *= bf_lo(a.z) * __builtin_amdgcn_rcpf(bf_lo(b.z)); a1[1] *= bf_hi(a.z) * __builtin_amdgcn_rcpf(bf_hi(b.z));
                a1[2] *= bf_lo(a.w) * __builtin_amdgcn_rcpf(bf_lo(b.w)); a1[3] *= bf_hi(a.w) * __builtin_amdgcn_rcpf(bf_hi(b.w)); } asm volatile("" ::: "memory"); }
    }
    __device__ __forceinline__ void operator()(const AccT& acc, const pg8::Unit& u, int wr, int wc, int fr, int fq) const {
        const int row0 = u.pm * 256 + wr * 64 + fr, col0 = u.pn * 256 + wc * 32 + 8 * fq;
        v4u bv[2][4][2];
        FOR_AI_M { const int row = row0 + ai * 128 + m * 16;
#pragma unroll
            for (int bj = 0; bj < 2; ++bj) bv[ai][m][bj] = *(const v4u*)(SB + (size_t)row * 1024 + col0 + bj * 128); }
        FOR_AI_M { const int row = row0 + ai * 128 + m * 16;
#pragma unroll
            for (int bj = 0; bj < 2; ++bj) { const size_t off = (size_t)row * 1024 + col0 + bj * 128; const v4u b = bv[ai][m][bj]; const f32x4 a0 = acc[ai][bj][m][0], a1 = acc[ai][bj][m][1];
                v4u w; w.x = cvt_pk_bf16(a0[0] * bf_lo(b.x), a0[1] * bf_hi(b.x)); w.y = cvt_pk_bf16(a0[2] * bf_lo(b.y), a0[3] * bf_hi(b.y));
                w.z = cvt_pk_bf16(a1[0] * bf_lo(b.z), a1[1] * bf_hi(b.z)); w.w = cvt_pk_bf16(a1[2] * bf_lo(b.w), a1[3] * bf_hi(b.w));
                *(v4u*)(MG + off) = w; } }
    }
};
template <bool XG, bool FIRST = false> struct EpiRes {
    static constexpr bool PERM = false, MID = false;
    float* X; const float* gate; const float* gv; bf16* XGo; float* SSo; const float* Xin; const float* posr; const float* posc;
    __device__ __forceinline__ void operator()(const AccT& acc, const pg8::Unit& u, int wr, int wc, int fr, int fq) const {
        const int row0 = u.pm * 256 + wr * 64 + fr, col0 = u.pn * 256 + wc * 32 + 4 * fq;
        const float* XL = FIRST ? Xin : X;
        const float* ptab = (u.pn < 2) ? posr + col0 : posc + (col0 - 512);
        f32x4 gg[2][2], gw[2][2];
#pragma unroll
        for (int bj = 0; bj < 2; ++bj)
#pragma unroll
            for (int n = 0; n < 2; ++n) { gg[bj][n] = *(const f32x4*)(gate + col0 + bj * 128 + n * 16); if (XG) gw[bj][n] = *(const f32x4*)(gv + col0 + bj * 128 + n * 16); }
        f32x4 cur[2][2], nxt[2][2];
        { const float* rp = XL + (size_t)row0 * D + col0; const float* pp = ptab + (size_t)((u.pn < 2) ? (row0 >> 6) : (row0 & 63)) * 512;
#pragma unroll
          for (int bj = 0; bj < 2; ++bj)
#pragma unroll
              for (int n = 0; n < 2; ++n) { cur[bj][n] = *(const f32x4*)(rp + bj * 128 + n * 16); if (FIRST) cur[bj][n] += *(const f32x4*)(pp + bj * 128 + n * 16); } }
#pragma unroll
        for (int it = 0; it < 8; ++it) { const int ai = it >> 2, m = it & 3; const int row = row0 + ai * 128 + m * 16; float* rp = X + (size_t)row * D + col0;
            if (it < 7) { const int r2 = row0 + ((it + 1) >> 2) * 128 + ((it + 1) & 3) * 16; const float* rn = XL + (size_t)r2 * D + col0; const float* pp = ptab + (size_t)((u.pn < 2) ? (r2 >> 6) : (r2 & 63)) * 512;
#pragma unroll
                for (int bj = 0; bj < 2; ++bj)
#pragma unroll
                    for (int n = 0; n < 2; ++n) { nxt[bj][n] = *(const f32x4*)(rn + bj * 128 + n * 16); if (FIRST) nxt[bj][n] += *(const f32x4*)(pp + bj * 128 + n * 16); } }
            asm volatile("" ::: "memory");
            float ss = 0.f;
#pragma unroll
            for (int bj = 0; bj < 2; ++bj)
#pragma unroll
                for (int n = 0; n < 2; ++n) { const f32x4 xv = cur[bj][n] + gg[bj][n] * acc[ai][bj][m][n]; *(f32x4*)(rp + bj * 128 + n * 16) = xv;
                    if (XG) { ss += (xv[0] * xv[0] + xv[1] * xv[1]) + (xv[2] * xv[2] + xv[3] * xv[3]); const f32x4 y = xv * gw[bj][n];
                        v2u w; w.x = cvt_pk_bf16(y[0], y[1]); w.y = cvt_pk_bf16(y[2], y[3]); *(v2u*)(XGo + (size_t)row * D + col0 + bj * 128 + n * 16) = w; } }
            if (XG) { ss += __shfl_xor(ss, 16); ss += __shfl_xor(ss, 32); if (fq == 0) atomicAdd(SSo + row, ss); }
            asm volatile("" ::: "memory");
#pragma unroll
            for (int bj = 0; bj < 2; ++bj)
#pragma unroll
                for (int n = 0; n < 2; ++n) cur[bj][n] = nxt[bj][n]; }
    }
};
struct EpiFfn {
    static constexpr bool PERM = true, MID = false;
    bf16* H; const float* SS; const float* CV;
    __device__ __forceinline__ void operator()(const AccT& acc, const pg8::Unit& u, int wr, int wc, int fr, int fq) const {
        const int row0 = u.pm * 256 + wr * 64 + fr, col0 = u.pn * 128 + wc * 32 + 8 * fq;
        const float* cv = CV + (u.pm >= 64 ? NCV : 0) + u.pn * 256 + wc * 32 + 8 * fq;
        const f32x4 c00 = *(const f32x4*)(cv), c01 = *(const f32x4*)(cv + 4), c10 = *(const f32x4*)(cv + 128), c11 = *(const f32x4*)(cv + 132);
        float rsv[2][4];
        FOR_AI_M rsv[ai][m] = SS[row0 + ai * 128 + m * 16];
        FOR_AI_M rsv[ai][m] = rsqrtf(rsv[ai][m] * (1.0f / D) + EPS);
        FOR_AI_M { const int row = row0 + ai * 128 + m * 16; const float rs = rsv[ai][m];
            const f32x4 g0 = acc[ai][0][m][0] * rs + c00, g1 = acc[ai][0][m][1] * rs + c01, u0 = acc[ai][1][m][0] * rs + c10, u1 = acc[ai][1][m][1] * rs + c11;
            v4u w; w.x = cvt_pk_bf16(silu_f(g0[0]) * u0[0], silu_f(g0[1]) * u0[1]); w.y = cvt_pk_bf16(silu_f(g0[2]) * u0[2], silu_f(g0[3]) * u0[3]);
            w.z = cvt_pk_bf16(silu_f(g1[0]) * u1[0], silu_f(g1[1]) * u1[1]); w.w = cvt_pk_bf16(silu_f(g1[2]) * u1[2], silu_f(g1[3]) * u1[3]);
            *(v4u*)(H + (size_t)row * FF + col0) = w; }
    }
};

struct Ctx { int tid, lane, wave, G, bid, wv; unsigned char* lds; unsigned char* ws; };
__device__ __forceinline__ Ctx mkctx(unsigned char* lds, unsigned char* ws, int wv) { Ctx C; C.wv = wv; int t = tid_of(wv); asm volatile("" : "+v"(t)); C.tid = t; C.lane = t & 63; C.wave = __builtin_amdgcn_readfirstlane(t >> 6); C.G = gridDim.x; C.bid = blockIdx.x; asm volatile("" : "+s"(ws)); C.lds = lds; C.ws = ws; return C; }

__device__ __forceinline__ void transpose_item(const float* W, int N, bf16* WT, int ldk, int koff, int drow0, int k0, int n0, float* scr, int lane, const float* sh, float* cvo) {
    { float tv[32]; const float* wp = W + (size_t)(k0 + (lane >> 5)) * N + n0 + (lane & 31);
#pragma unroll
      for (int i = 0; i < 32; ++i) tv[i] = wp[(size_t)(2 * i) * N];
#pragma unroll
      for (int i = 0; i < 32; ++i) scr[(2 * i + (lane >> 5)) * 33 + (lane & 31)] = tv[i]; }
    asm volatile("s_waitcnt lgkmcnt(0)" ::: "memory");
    if (sh) {
        float a0 = 0.f, a1 = 0.f;
#pragma unroll 16
        for (int kk = 0; kk < 64; ++kk) { const float w = scr[kk * 33 + (lane & 31)]; a0 = fmaf(sh[k0 + kk], w, a0); a1 = fmaf(sh[NMOD + k0 + kk], w, a1); }
        if (lane < 32) { atomicAdd(cvo + drow0 + lane, a0); atomicAdd(cvo + NCV + drow0 + lane, a1); }
    }
    const int c = lane & 7;
#pragma unroll
    for (int j = 0; j < 4; ++j) { const int n = (lane >> 3) + 8 * j; const float* s = scr + (8 * c) * 33 + n;
        v4u o; o.x = cvt_pk_bf16(s[0 * 33], s[1 * 33]); o.y = cvt_pk_bf16(s[2 * 33], s[3 * 33]); o.z = cvt_pk_bf16(s[4 * 33], s[5 * 33]); o.w = cvt_pk_bf16(s[6 * 33], s[7 * 33]);
        *(v4u*)(WT + (size_t)(drow0 + n) * ldk + koff + k0 + 8 * c) = o; }
    asm volatile("s_waitcnt lgkmcnt(0)" ::: "memory");
}
__device__ __forceinline__ bool transpose_job(int& it, const float* W, int K, int N, bf16* WT, int ldk, int koff, int mode, float* scr, int lane, const float* sh = nullptr, float* cvo = nullptr) {
    const int nblk = N / 32, items = (K / 64) * nblk;
    if (it >= items) { it -= items; return false; }
    const int kb = it / nblk, nb = it % nblk, n0 = 32 * nb; int dr = n0;
    if (mode == 1) { if (n0 >= 512 && n0 < 1536) { const int c = n0 - 512; dr = 512 + (c >> 7) * 256 + (c & 127); } else if (n0 >= 1536 && n0 < 2560) { const int c = n0 - 1536; dr = 512 + (c >> 7) * 256 + 128 + (c & 127); } }
    else if (mode == 2) dr = (n0 >> 7) * 256 + (n0 & 127);
    else if (mode == 3) dr = (n0 >> 7) * 256 + 128 + (n0 & 127);
    transpose_item(W, N, WT, ldk, koff, dr, 64 * kb, n0, scr, lane, sh, cvo);
    return true;
}

__device__ __forceinline__ void rows_first(const Ctx& C0) {
    const Ctx C = mkctx(C0.lds, C0.ws, C0.wv); const Params P = load_params();
    const int gw = C.bid * NWAVES + C.wave, NGW = C.G * NWAVES, lane = C.lane;
    const float* modl = (const float*)(C.ws + WS_MOD);
    const float* posr = (const float*)(C.ws + WS_POSR); const float* posc = (const float*)(C.ws + WS_POSC);
    float* XC = (float*)(C.ws + WS_XC); float* SS = (float*)(C.ws + WS_SS); bf16* Hout = (bf16*)(C.ws + WS_XR);
    f32x4 gn[4];
#pragma unroll
    for (int j = 0; j < 4; ++j) gn[j] = *(const f32x4*)(P.norm1_g + 4 * lane + 256 * j);
    for (int row = gw; row < MR; row += NGW) {
        const bool isc = row >= SEQ; const float* mv = modl + (isc ? NMOD : 0);
        f32x4 v[4];
        if (isc) {
#pragma unroll
            for (int j = 0; j < 4; ++j) v[j] = *(const f32x4*)(P.ctx + (size_t)(row - SEQ) * D + 4 * lane + 256 * j);
        } else {
            const int pr = row >> 6, pc = row & 63;
#pragma unroll
            for (int j = 0; j < 4; ++j) { const int ch = 4 * lane + 256 * j; const f32x4 pe = (j < 2) ? *(const f32x4*)(posr + pr * 512 + ch) : *(const f32x4*)(posc + pc * 512 + ch - 512);
                v[j] = *(const f32x4*)(P.x + (size_t)row * D + ch) + pe; }
        }
        float* xo = isc ? XC + (size_t)(row - SEQ) * D : P.out + (size_t)row * D;
        float ss = 0.f;
#pragma unroll
        for (int j = 0; j < 4; ++j) { *(f32x4*)(xo + 4 * lane + 256 * j) = v[j]; ss += (v[j][0] * v[j][0] + v[j][1] * v[j][1]) + (v[j][2] * v[j][2] + v[j][3] * v[j][3]); }
        ss = wave_sum(ss); if (lane == 0) SS[row] = ss;
#pragma unroll
        for (int j = 0; j < 4; ++j) { const int ch = 4 * lane + 256 * j; const f32x4 sc = *(const f32x4*)(mv + D + ch);
            const f32x4 y = v[j] * gn[j] * (sc + 1.0f);
            v2u w; w.x = cvt_pk_bf16(y[0], y[1]); w.y = cvt_pk_bf16(y[2], y[3]);
            *(v2u*)(Hout + (size_t)row * D + ch) = w; }
    }
    for (int it = C.bid * NT + C.tid; it < 2 * 2 * 2 * D; it += C.G * NT) { const int k = it & (D - 1), nrm = (it >> 10) & 1, wh = (it >> 11) & 1, l = it >> 12;
        const float g = (nrm ? P.norm2_g : P.norm1_g)[l * D + k]; ((float*)(C.ws + WS_GV))[it] = g * (1.0f + modl[(size_t)(l * 2 + wh) * NMOD + (nrm ? 4 * D : D) + k]); }
}

__device__ __forceinline__ void phase_setup(const Ctx& C0) {
    const Ctx C = mkctx(C0.lds, C0.ws, C0.wv); const Params P = load_params(); (void)P;
    float* red = (float*)C.lds;
    for (int b = C.bid; b < 192; b += C.G) {
        const int l = b / 96, n0 = (b % 96) * 64, k0 = C.wave * 128;
        const float* W = P.w_mod + (size_t)l * D * NMOD + n0 + C.lane;
        float a0 = 0.f, a1 = 0.f;
#pragma unroll 32
        for (int k = 0; k < 128; ++k) { const float w = W[(size_t)(k0 + k) * NMOD]; a0 = fmaf(silu_f(P.c[k0 + k]), w, a0); a1 = fmaf(silu_f(P.c_ctx[k0 + k]), w, a1); }
        red[(C.wave * 2 + 0) * 64 + C.lane] = a0; red[(C.wave * 2 + 1) * 64 + C.lane] = a1;
        __syncthreads();
        if (C.wave < 2) { float s = 0.f;
#pragma unroll
            for (int w = 0; w < 8; ++w) s += red[(w * 2 + C.wave) * 64 + C.lane];
            ((float*)(C.ws + WS_MOD))[(size_t)(l * 2 + C.wave) * NMOD + n0 + C.lane] = s + P.b_mod[(size_t)l * NMOD + n0 + C.lane]; }
        __syncthreads();
    }
    const int gt = C.bid * NT + C.tid, NGT = C.G * NT;
    for (int it = gt; it < 4 * MR; it += NGT) ((float*)(C.ws + WS_SS))[it] = 0.f;
    for (int it = gt; it < 4 * NCV; it += NGT) ((float*)(C.ws + WS_CV))[it] = 0.f;
    for (int it = gt; it < 8192; it += NGT) {
        const float lr = P.lam_re[it], li = P.lam_im[it], dt = expf(P.log_step[it >> 6]);
        const float mag = expf(lr * dt); float sn, cs; sincos_cw(li * dt, sn, cs);
        const float ar = mag * cs, ai = mag * sn, nr = ar - 1.0f, ni = ai, den = lr * lr + li * li;
        const float fr_ = (nr * lr + ni * li) / den, fi_ = (ni * lr - nr * li) / den;
        float* ap = (float*)(C.ws + WS_APOW) + (size_t)it * 34; float pr = 1.f, pi = 0.f;
        for (int t = 0; t <= 16; ++t) { ap[2 * t] = pr; ap[2 * t + 1] = pi; const float qr = pr * ar - pi * ai, qi = pr * ai + pi * ar; if (t == 16) { ((float*)(C.ws + WS_A16))[2 * it] = pr; ((float*)(C.ws + WS_A16))[2 * it + 1] = pi; } pr = qr; pi = qi; }
        float* bt = (float*)(C.ws + WS_BTC) + (size_t)it * 32;
        for (int c = 0; c < 16; ++c) { const float br = P.b_re[(size_t)it * 16 + c], bi = P.b_im[(size_t)it * 16 + c]; bt[2 * c] = fr_ * br - fi_ * bi; bt[2 * c + 1] = fr_ * bi + fi_ * br; }
    }
    for (int it = gt; it < 320 * 256; it += NGT) {
        const int r = it >> 8, i = it & 255; const float om = 1.0f / powf(10000.0f, (float)i * (1.0f / 256.0f));
        const float pv = (float)(r < 256 ? r : r - 256); float sn, cs; sincos_cw(pv * om, sn, cs);
        float* T = (r < 256) ? (float*)(C.ws + WS_POSR) + (size_t)r * 512 : (float*)(C.ws + WS_POSC) + (size_t)(r - 256) * 512;
        T[i] = sn; T[256 + i] = cs;
    }
}

__device__ __forceinline__ void build_s5_mats(const Ctx& C0, int l, int sb, int sG) {
    const Ctx C = mkctx(C0.lds, C0.ws, C0.wv); const Params P = load_params();
    const int tid = C.tid;
    float* AP = (float*)C.lds;
    float* BT = AP + 2 * 64 * 34;
    float* CR = BT + 2 * 64 * 32;
    float* CI = CR + 2 * 16 * 64;
    bf16* BAMl = (bf16*)(C.ws + (l ? WS_BAM1 : WS_BAM)); bf16* TCl = (bf16*)(C.ws + (l ? WS_TC1 : WS_TC));
    __syncthreads();
    for (int w = sb; w < NG * 8; w += sG) {
        const int g = w & 31, sub = w >> 5;
#pragma unroll
        for (int d = 0; d < 2; ++d) {
            const float* apg = (const float*)(C.ws + WS_APOW) + ((size_t)l * 4096 + (size_t)(d * NG + g) * NP) * 34;
            const float* btg = (const float*)(C.ws + WS_BTC) + ((size_t)l * 4096 + (size_t)(d * NG + g) * NP) * 32;
            const float* crg = P.c_re + ((size_t)(l * 2 + d) * NG + g) * 16 * NP; const float* cig = P.c_im + ((size_t)(l * 2 + d) * NG + g) * 16 * NP;
            for (int i = tid; i < 64 * 34; i += NT) AP[d * 64 * 34 + i] = apg[i];
            for (int i = tid; i < 64 * 32; i += NT) BT[d * 64 * 32 + i] = btg[i];
            for (int i = tid; i < 16 * 64; i += NT) { CR[d * 1024 + i] = crg[i]; CI[d * 1024 + i] = cig[i]; }
        }
        __syncthreads();
        bf16* T = TCl + (size_t)g * 256 * 512;
        { const int cp = tid & 15, c = (tid >> 4) & 15, tau = 2 * sub + (tid >> 8);
          float kk[2];
#pragma unroll
          for (int d = 0; d < 2; ++d) { float sacc = 0.f; const float* cr = CR + d * 1024 + c * 64; const float* ci = CI + d * 1024 + c * 64; const float* ap = AP + d * 64 * 34 + 2 * tau; const float* bt = BT + d * 64 * 32 + 2 * cp;
#pragma unroll 16
              for (int p = 0; p < NP; ++p) { const float pr = ap[p * 34], pi = ap[p * 34 + 1], br = bt[p * 32], bi = bt[p * 32 + 1];
                  const float zr = pr * br - pi * bi, zi = pr * bi + pi * br; sacc += cr[p] * zr - ci[p] * zi; }
              kk[d] = sacc; }
          if (tau == 0) { const bf16 v = (bf16)f2bf(kk[0] + kk[1] + (c == cp ? P.ssm_d[(size_t)l * SSMW + g * 16 + c] : 0.f)); for (int t = 0; t < 16; ++t) T[(size_t)(t * 16 + c) * 512 + t * 16 + cp] = v; }
          else { const bf16 vf = (bf16)f2bf(kk[0]), vr = (bf16)f2bf(kk[1]);
              for (int t = tau; t < 16; ++t) { T[(size_t)(t * 16 + c) * 512 + (t - tau) * 16 + cp] = vf; T[(size_t)((t - tau) * 16 + c) * 512 + t * 16 + cp] = vr; } } }
#pragma unroll
        for (int j8 = 0; j8 < 8; ++j8) { const int it = tid + NT * j8; const int p = it & 63, d = (it >> 6) & 1, c = (it >> 7) & 15, t = 2 * sub + (it >> 11);
            const int e = d ? 16 - t : t + 1; const float cr = CR[d * 1024 + c * 64 + p], ci = CI[d * 1024 + c * 64 + p]; const float* ap = AP + (d * 64 + p) * 34 + 2 * e;
            const float wr_ = cr * ap[0] - ci * ap[1], wi_ = cr * ap[1] + ci * ap[0];
            bf16* Tr = T + (size_t)(t * 16 + c) * 512 + 256 + d * 128 + p;
            Tr[0] = (bf16)f2bf(wr_); Tr[64] = (bf16)f2bf(-wi_); }
#pragma unroll
        for (int j8 = 0; j8 < 8; ++j8) { const int it = tid + NT * j8; const int cp = it & 15, j = 2 * sub + ((it >> 4) & 1), p = (it >> 5) & 63, d = it >> 11;
            const int e = d ? j : 15 - j; const float* ap = AP + (d * 64 + p) * 34 + 2 * e; const float* bt = BT + (d * 64 + p) * 32 + 2 * cp;
            const float vr = ap[0] * bt[0] - ap[1] * bt[1], vi = ap[0] * bt[1] + ap[1] * bt[0];
            bf16* B = BAMl + ((size_t)g * 256 + d * 128 + p) * 256 + j * 16 + cp;
            B[0] = (bf16)f2bf(vr); B[(size_t)64 * 256] = (bf16)f2bf(vi); }
        __syncthreads();
    }
}

#define GAS __attribute__((address_space(1)))
template <int DIR, int N>
__device__ __forceinline__ void run_load(__amdgpu_buffer_rsrc_t RS, unsigned vs, float (&sr)[N], float (&si)[N]) {
    constexpr int STS = (DIR ? -8192 : 8192) * 4;
    const int bs = (int)(vs * 4u) + (DIR ? (N - 1) * STS : 0);
#pragma unroll
    for (int k = 0; k < N; ++k) { const int so = DIR ? (N - 1 - k) * (-STS) : k * STS; sr[k] = __builtin_bit_cast(float, __builtin_amdgcn_raw_buffer_load_b32(RS, bs, so, 0)); si[k] = __builtin_bit_cast(float, __builtin_amdgcn_raw_buffer_load_b32(RS, bs + 256, so, 0)); }
}
template <int DIR, int N, bool WRITE>
__device__ __forceinline__ void run_scan(__amdgpu_buffer_rsrc_t RH, unsigned vre, unsigned vim, const float (&sr)[N], const float (&si)[N], float ar, float ai, float& hr, float& hi) {
    constexpr int STH = (DIR ? -8192 : 8192) * 2;
    const int bre = (int)(vre * 2u) + (DIR ? (N - 1) * STH : 0), bim = (int)(vim * 2u) + (DIR ? (N - 1) * STH : 0);
#pragma unroll
    for (int k = 0; k < N; ++k) {
        if (WRITE) { const int so = DIR ? (N - 1 - k) * (-STH) : k * STH; __builtin_amdgcn_raw_buffer_store_b16((short)f2bf(hr), RH, bre, so, 0); __builtin_amdgcn_raw_buffer_store_b16((short)f2bf(hi), RH, bim, so, 0); }
        const float nr = ar * hr - ai * hi + sr[k], ni = ar * hi + ai * hr + si[k]; hr = nr; hi = ni; }
}
template <int DIR>
__device__ __forceinline__ void carry_scan_d(const Ctx& C, int l, int g) {
    constexpr int d = DIR; const int p = C.lane, w = C.wave;
    const __amdgpu_buffer_rsrc_t S = __builtin_amdgcn_make_buffer_rsrc((void*)(C.ws + WS_XR), 0, 0x7ffffffe, 0x00020000);
    const __amdgpu_buffer_rsrc_t H = __builtin_amdgcn_make_buffer_rsrc((void*)(C.ws + WS_HST), 0, 0x7ffffffe, 0x00020000);
    const float* a16p = (const float*)(C.ws + WS_A16) + 2 * ((size_t)((l * 2 + d) * NG + g) * NP + p);
    const float ar = a16p[0], ai = a16p[1];
    const int nre = d * 128 + p, nim = nre + 64;
    const unsigned ls = (unsigned)(g * 256 + d * 128 + p), lre = (unsigned)((nre >> 4) * 512 + g * 16 + (nre & 15)), lim = (unsigned)((nim >> 4) * 512 + g * 16 + (nim & 15));
    const int cc0 = DIR ? NCH - 1 : SEQ / 16;
    const int lc0 = DIR ? (SEQ / 16 - 1 - 128 * w) : 128 * w;
    constexpr int QS = DIR ? -32 : 32;
    const unsigned c0 = (unsigned)lc0 * 8192u, c1 = (unsigned)(lc0 + QS) * 8192u, c2 = (unsigned)(lc0 + 2 * QS) * 8192u, c3 = (unsigned)(lc0 + 3 * QS) * 8192u, cc = (unsigned)cc0 * 8192u;
    float* ends = (float*)C.lds;
    float er = 0.f, ei = 0.f, hr = 0.f, hi = 0.f;
    float q3r[32], q3i[32];
    {   float xr[16], xi[16], ar0[32], ai0[32], ar1[32], ai1[32];
        run_load<DIR, 16>(S, cc + ls, xr, xi); run_load<DIR, 32>(S, c0 + ls, ar0, ai0); run_load<DIR, 32>(S, c1 + ls, ar1, ai1);
        if (w == 0) run_scan<DIR, 16, true>(H, cc + lre, cc + lim, xr, xi, ar, ai, er, ei); else run_scan<DIR, 16, false>(H, 0u, 0u, xr, xi, ar, ai, er, ei);
        run_scan<DIR, 32, false>(H, 0u, 0u, ar0, ai0, ar, ai, hr, hi); run_scan<DIR, 32, false>(H, 0u, 0u, ar1, ai1, ar, ai, hr, hi); }
    {   float br[32], bi[32];
        run_load<DIR, 32>(S, c2 + ls, br, bi); run_load<DIR, 32>(S, c3 + ls, q3r, q3i);
        run_scan<DIR, 32, false>(H, 0u, 0u, br, bi, ar, ai, hr, hi); run_scan<DIR, 32, false>(H, 0u, 0u, q3r, q3i, ar, ai, hr, hi); }
    ends[(w * 64 + p) * 2] = hr; ends[(w * 64 + p) * 2 + 1] = hi;
    float pr = ar, pi = ai;
#pragma unroll
    for (int i = 0; i < 7; ++i) { const float qr = pr * pr - pi * pi, qi = 2.f * pr * pi; pr = qr; pi = qi; }
    float ar0[32], ai0[32], ar1[32], ai1[32];
    run_load<DIR, 32>(S, c0 + ls, ar0, ai0); run_load<DIR, 32>(S, c1 + ls, ar1, ai1);
    __syncthreads();
    hr = er; hi = ei;
    for (int ww = 0; ww < w; ++ww) { const float xr = ends[(ww * 64 + p) * 2], xi = ends[(ww * 64 + p) * 2 + 1]; const float nr = pr * hr - pi * hi + xr, ni = pr * hi + pi * hr + xi; hr = nr; hi = ni; }
    run_scan<DIR, 32, true>(H, c0 + lre, c0 + lim, ar0, ai0, ar, ai, hr, hi);
    { float br[32], bi[32]; run_load<DIR, 32>(S, c2 + ls, br, bi);
      run_scan<DIR, 32, true>(H, c1 + lre, c1 + lim, ar1, ai1, ar, ai, hr, hi);
      run_scan<DIR, 32, true>(H, c2 + lre, c2 + lim, br, bi, ar, ai, hr, hi); }
    run_scan<DIR, 32, true>(H, c3 + lre, c3 + lim, q3r, q3i, ar, ai, hr, hi);
    __syncthreads();
}
__device__ __forceinline__ void carry_scan(const Ctx& C0, int l, int gd) {
    const Ctx C = mkctx(C0.lds, C0.ws, C0.wv);
    if (gd & 1) carry_scan_d<1>(C, l, gd >> 1); else carry_scan_d<0>(C, l, gd >> 1);
}

template <int RR> struct ConvStep {
    static __device__ __forceinline__ void run(f32x2 (&acc)[32], const f32x2 (&wk)[31], const GAS bf16* VB, int r0, int len) {
        ConvStep<RR - 1>::run(acc, wk, VB, r0, len);
        const int ir = r0 - 15 + RR, irc = ir < 0 ? 0 : (ir >= len ? len - 1 : ir);
        unsigned raw = *(const GAS unsigned*)(VB + (size_t)irc * D); raw = (ir == irc) ? raw : 0u;
        const f32x2 v = (f32x2){bf_lo(raw), bf_hi(raw)};
        constexpr int J0 = RR - 30 > 0 ? RR - 30 : 0, J1 = RR < 31 ? RR : 31;
#pragma unroll
        for (int j = J0; j <= J1; ++j) acc[j] += v * wk[RR - j];
    }
};
template <> struct ConvStep<-1> { static __device__ __forceinline__ void run(f32x2 (&)[32], const f32x2 (&)[31], const GAS bf16*, int, int) {} };
__device__ __forceinline__ void conv_tile(const Ctx& C0, int l, int tile) {
    const Ctx C = mkctx(C0.lds, C0.ws, C0.wv); const Params P = load_params();
    const int tid = C.tid; const bool isc = tile >= SEQ / 32; const int base = isc ? SEQ : 0, len = isc ? CTXN : SEQ, r0 = (isc ? tile - SEQ / 32 : tile) * 32;
    const GAS bf16* VB = (const GAS bf16*)(C.ws + WS_VB) + (size_t)base * D + 2 * tid;
    const float* dw = P.dw_kernel + (size_t)l * 31 * D + 2 * tid;
    f32x2 wk[31];
#pragma unroll
    for (int k = 0; k < 31; ++k) wk[k] = *(const f32x2*)(dw + (size_t)k * D);
    const f32x2 bias = *(const f32x2*)(P.dw_bias + (size_t)l * D + 2 * tid);
    f32x2 acc[32];
#pragma unroll
    for (int j = 0; j < 32; ++j) acc[j] = bias;
    ConvStep<61>::run(acc, wk, VB, r0, len);
    float* tl = (float*)C.lds;
#pragma unroll
    for (int j = 0; j < 32; ++j) *(f32x2*)(tl + j * D + 2 * tid) = acc[j];
    __syncthreads();
    bf16* A2 = (bf16*)(C.ws + WS_A2);
    const float* cg = P.cn_g + (size_t)l * D; const float* cb = P.cn_b + (size_t)l * D;
#pragma unroll
    for (int jj = 0; jj < 4; ++jj) { const int j = C.wave * 4 + jj; f32x4 v[4]; float s = 0.f;
#pragma unroll
        for (int q = 0; q < 4; ++q) { v[q] = *(const f32x4*)(tl + j * D + 4 * C.lane + 256 * q); s += (v[q][0] + v[q][1]) + (v[q][2] + v[q][3]); }
        const float mu = wave_sum(s) * (1.0f / D); float s2 = 0.f;
#pragma unroll
        for (int q = 0; q < 4; ++q) { v[q] = v[q] - mu; s2 += (v[q][0] * v[q][0] + v[q][1] * v[q][1]) + (v[q][2] * v[q][2] + v[q][3] * v[q][3]); }
        const float rstd = rsqrtf(wave_sum(s2) * (1.0f / D) + EPS);
#pragma unroll
        for (int q = 0; q < 4; ++q) { const int ch = 4 * C.lane + 256 * q; const f32x4 y = v[q] * rstd * *(const f32x4*)(cg + ch) + *(const f32x4*)(cb + ch);
            v2u w; w.x = cvt_pk_bf16(silu_f(y[0]), silu_f(y[1])); w.y = cvt_pk_bf16(silu_f(y[2]), silu_f(y[3]));
            *(v2u*)(A2 + (size_t)(base + r0 + j) * 1536 + 512 + ch) = w; } }
    __syncthreads();
}

__device__ __forceinline__ void rows_final(const Ctx& C0) {
    const Ctx C = mkctx(C0.lds, C0.ws, C0.wv); const Params P = load_params(); (void)P;
    const int gw = C.bid * NWAVES + C.wave, NGW = C.G * NWAVES, lane = C.lane;
    f32x4 gn[4];
#pragma unroll
    for (int j = 0; j < 4; ++j) gn[j] = *(const f32x4*)(P.norm_f_g + 4 * lane + 256 * j);
    for (int row = gw; row < SEQ; row += NGW) { float* xr = P.out + (size_t)row * D; f32x4 v[4]; float ss = 0.f;
#pragma unroll
        for (int j = 0; j < 4; ++j) { v[j] = *(const f32x4*)(xr + 4 * lane + 256 * j); ss += (v[j][0] * v[j][0] + v[j][1] * v[j][1]) + (v[j][2] * v[j][2] + v[j][3] * v[j][3]); }
        const float rstd = rsqrtf(wave_sum(ss) * (1.0f / D) + EPS);
#pragma unroll
        for (int j = 0; j < 4; ++j) *(f32x4*)(xr + 4 * lane + 256 * j) = v[j] * rstd * gn[j]; }
}


template <int K, int LDA, int MODE>
__device__ __forceinline__ void ctx_gemm(int wv, unsigned char* lds, const bf16* A, const bf16* Bt, const bf16* SA, const bf16* SB, bf16* MG, float* XC, const float* gate, const float* gv, bf16* XGo, float* SSo) {
    int t_ = tid_of(wv); asm volatile("" : "+v"(t_));
    const int lane = t_ & 63, wave = wv, r = lane & 15, q = lane >> 4, half = wave >> 2, w4 = wave & 3;
    constexpr int K0 = (MODE == 0) ? 512 : K / 2;
    pg8::f32x4* xch = (pg8::f32x4*)lds;
    for (int t0 = blockIdx.x * 4; t0 < 16 * 64; t0 += gridDim.x * 4) {
        const int task = t0 + w4, ni = task >> 4, mi = task & 15;
        const bf16* ap = A + (size_t)(mi * 16 + r) * LDA + 8 * q; const bf16* bp = Bt + (size_t)(ni * 16 + r) * K + 8 * q;
        pg8::f32x4 acc = {0.f, 0.f, 0.f, 0.f};
        constexpr int NS0 = K0 / 32, NS1 = (K - K0) / 32;
        if (!half) {
#pragma unroll 16
            for (int i = 0; i < NS0; ++i) { const pg8::bf16x8 a = *(const pg8::bf16x8*)(ap + 32 * i), b = *(const pg8::bf16x8*)(bp + 32 * i); acc = __builtin_amdgcn_mfma_f32_16x16x32_bf16(b, a, acc, 0, 0, 0); }
        } else {
#pragma unroll 16
            for (int i = 0; i < NS1; ++i) { const pg8::bf16x8 a = *(const pg8::bf16x8*)(ap + K0 + 32 * i), b = *(const pg8::bf16x8*)(bp + K0 + 32 * i); acc = __builtin_amdgcn_mfma_f32_16x16x32_bf16(b, a, acc, 0, 0, 0); }
        }
        if (half) xch[w4 * 64 + lane] = acc;
        __syncthreads();
        if (!half) {
            const pg8::f32x4 acc2 = xch[w4 * 64 + lane];
            const int row = mi * 16 + r, col = ni * 16 + 4 * q;
            if (MODE == 0) { const size_t off = (size_t)(SEQ + row) * D + col; const v2u a = *(const v2u*)(SA + off), b = *(const v2u*)(SB + off);
                v2u w; w.x = cvt_pk_bf16(bf_lo(a.x) * acc[0] + bf_lo(b.x) * acc2[0], bf_hi(a.x) * acc[1] + bf_hi(b.x) * acc2[1]);
                w.y = cvt_pk_bf16(bf_lo(a.y) * acc[2] + bf_lo(b.y) * acc2[2], bf_hi(a.y) * acc[3] + bf_hi(b.y) * acc2[3]);
                *(v2u*)(MG + off) = w; }
            else { f32x4* p = (f32x4*)(XC + (size_t)row * D + col); const f32x4 g = *(const f32x4*)(gate + col); f32x4 a4 = {acc[0] + acc2[0], acc[1] + acc2[1], acc[2] + acc2[2], acc[3] + acc2[3]}; const f32x4 xv = *p + g * a4; *p = xv;
                const f32x4 y = xv * *(const f32x4*)(gv + col); v2u w; w.x = cvt_pk_bf16(y[0], y[1]); w.y = cvt_pk_bf16(y[2], y[3]); *(v2u*)(XGo + (size_t)(SEQ + row) * D + col) = w;
                float ss = (xv[0] * xv[0] + xv[1] * xv[1]) + (xv[2] * xv[2] + xv[3] * xv[3]); ss += __shfl_xor(ss, 16); ss += __shfl_xor(ss, 32); if (q == 0) atomicAdd(SSo + SEQ + row, ss); }
        }
        __syncthreads();
    }
}

__device__ __forceinline__ void mixer_prep(unsigned char* lds, int wv, int l, int sb, int sG) {
    const Params P = load_params(); unsigned char* ws = P.ws; const Ctx C1 = mkctx(lds, ws, wv); float* scr = (float*)(lds + C1.wave * 16384);
    const float* sh = (const float*)(ws + WS_MOD) + (size_t)l * 2 * NMOD;
    float* cvo = (float*)(ws + WS_CV) + (size_t)l * 2 * NCV;
    for (int it0 = sb * NWAVES + C1.wave; ; it0 += sG * NWAVES) { int it = it0;
        if (transpose_job(it, P.w_in + (size_t)l * D * WIN, D, WIN, (bf16*)(ws + WS_WIN), D, 0, 1, scr, C1.lane, sh, cvo)) continue;
        if (transpose_job(it, P.w_glu + (size_t)l * SSMW * SSMW, SSMW, SSMW, (bf16*)(ws + WS_WGLU), SSMW, 0, 0, scr, C1.lane)) continue;
        if (transpose_job(it, P.w_proj_a + (size_t)l * SSMW * D, SSMW, D, (bf16*)(ws + WS_WPROJ), 1536, 0, 0, scr, C1.lane)) continue;
        if (transpose_job(it, P.w_proj_b + (size_t)l * D * D, D, D, (bf16*)(ws + WS_WPROJ), 1536, 512, 0, scr, C1.lane)) continue;
        if (transpose_job(it, P.w_out + (size_t)l * D * D, D, D, (bf16*)(ws + WS_WOUT), D, 0, 0, scr, C1.lane)) continue;
        break; }
}
__device__ __forceinline__ void ffn_prep(unsigned char* lds, int wv, int l, int sb, int sG) {
    const Params P = load_params(); unsigned char* ws = P.ws; const Ctx C1 = mkctx(lds, ws, wv); float* scr = (float*)(lds + C1.wave * 16384);
    const float* sh = (const float*)(ws + WS_MOD) + (size_t)l * 2 * NMOD + 3 * D;
    float* cvo = (float*)(ws + WS_CV) + (size_t)l * 2 * NCV + WIN;
    for (int it0 = sb * NWAVES + C1.wave; ; it0 += sG * NWAVES) { int it = it0;
        if (transpose_job(it, P.w_gate + (size_t)l * D * FF, D, FF, (bf16*)(ws + WS_WGU), D, 0, 2, scr, C1.lane, sh, cvo)) continue;
        if (transpose_job(it, P.w_up + (size_t)l * D * FF, D, FF, (bf16*)(ws + WS_WGU), D, 0, 3, scr, C1.lane, sh, cvo)) continue;
        if (transpose_job(it, P.w_down + (size_t)l * FF * D, FF, D, (bf16*)(ws + WS_WD), FF, 0, 0, scr, C1.lane)) continue;
        break; }
}

__device__ __forceinline__ void conv_grab(const Ctx& C0, int l, int maxn) {
    unsigned* cnt = (unsigned*)(C0.ws + WS_CTL) + 8192 + 64 * l;
    volatile LAS unsigned* slot = (volatile LAS unsigned*)((LAS unsigned char*)C0.lds + MISC_OFF) + 16;
    for (int n = 0; n < maxn; ++n) {
        if (tid_of(C0.wv) == 0) slot[0] = atomicAdd(cnt, 1u);
        __syncthreads();
        const int tile = (int)slot[0];
        __syncthreads();
        if (tile >= MR / 32) break;
        conv_tile(C0, l, tile);
    }
}

#define GRID_BAR() xcd_barrier(bar)
template <int L>
__device__ __forceinline__ void layer_body(const Ctx& C, unsigned char* lds, PG8_LAS unsigned char* ldsl, int wv, const XcdBarrier& bar) {
        constexpr int l = L; constexpr bool last = (L == 1);
        constexpr int mr = last ? SEQ : MR;
        { unsigned char* ws = load_params().ws; typedef pg8::Cfg<D, D, 16, 1 << 30, -1, 0> CF; pg8::Gemm g{(const bf16*)(ws + WS_XR), (const bf16*)(ws + WS_XR), (const bf16*)(ws + WS_WIN)};
          pg8::StaticOrder S; S.init(MR, WIN, C.G, C.bid);
          EpiWin E{(bf16*)(ws + WS_U), (bf16*)(ws + WS_VB), (bf16*)(ws + WS_SA), (bf16*)(ws + WS_SB), (const float*)(ws + WS_SS) + (size_t)(l * 2) * MR, (const float*)(ws + WS_CV) + (size_t)l * 2 * NCV};
          pg8::gemm_phase<CF>(ldsl, g, S, E, wv); }
        GRID_BAR();
        { unsigned char* ws = load_params().ws; typedef pg8::Cfg<256, 16 * SSMW, SSMW, 1 << 30, -1, 16> CF; pg8::Gemm g{(const bf16*)(ws + WS_U), (const bf16*)(ws + WS_U), (const bf16*)(ws + (l ? WS_BAM1 : WS_BAM))};
          pg8::StaticOrder S; S.init(NCHP, NG * 256, C.G, C.bid);
          EpiS1 E{(float*)(ws + WS_XR)};
          pg8::gemm_phase<CF>(ldsl, g, S, E, wv);
          if (C.bid >= (NCHP / 256) * NG) conv_grab(C, l, 1); }
        GRID_BAR();
        { if (C.G > 64) { if (C.bid < 64) carry_scan(C, l, C.bid); else conv_grab(C, l, 2); }
          else { for (int gd = C.bid; gd < 64; gd += C.G) carry_scan(C, l, gd); conv_grab(C, l, 2); } }
        GRID_BAR();
        { unsigned char* ws = load_params().ws; typedef pg8::Cfg<512, 16 * SSMW, SSMW, 4, -1, 16> CF; pg8::Gemm g{(const bf16*)(ws + WS_U), (const bf16*)(ws + WS_HST), (const bf16*)(ws + (l ? WS_TC1 : WS_TC))};
          pg8::StaticOrder S; S.init(NCHP, NG * 256, C.G, C.bid);
          EpiS3 E{(bf16*)(ws + WS_XR)};
          pg8::gemm_phase<CF>(ldsl, g, S, E, wv);
          if (C.bid >= (NCHP / 256) * NG) conv_grab(C, l, 1 << 20); else if (C.G <= (NCHP / 256) * NG) conv_grab(C, l, 1 << 20); }
        GRID_BAR();
        { unsigned char* ws = load_params().ws; typedef pg8::Cfg<SSMW, SSMW, 16, 1 << 30, -1, 0> CF; pg8::Gemm g{(const bf16*)(ws + WS_XR), (const bf16*)(ws + WS_XR), (const bf16*)(ws + WS_WGLU)};
          pg8::StaticOrder S; S.init(mr, SSMW, C.G, C.bid);
          EpiGlu E{(const bf16*)(ws + WS_XR), (bf16*)(ws + WS_A2)};
          pg8::gemm_phase<CF>(ldsl, g, S, E, wv);
          const int nu = (mr / 256) * 2;
          if (C.G > nu) { if (C.bid >= nu) ffn_prep(lds, wv, l, C.bid - nu, C.G - nu); } else ffn_prep(lds, wv, l, C.bid, C.G); }
        GRID_BAR();
        { unsigned char* ws = load_params().ws; typedef pg8::Cfg<1536, 1536, 16, 1 << 30, 8, 0> CF; pg8::Gemm g{(const bf16*)(ws + WS_A2), (const bf16*)(ws + WS_A2), (const bf16*)(ws + WS_WPROJ)};
          pg8::StaticOrder S; S.init(SEQ, D, C.G, C.bid);
          EpiMerged E{(const bf16*)(ws + WS_SA), (const bf16*)(ws + WS_SB), (bf16*)(ws + WS_VB)};
          pg8::gemm_phase<CF>(ldsl, g, S, E, wv);
          if constexpr (!last) ctx_gemm<1536, 1536, 0>(wv, lds, (const bf16*)(ws + WS_A2) + (size_t)SEQ * 1536, (const bf16*)(ws + WS_WPROJ), (const bf16*)(ws + WS_SA), (const bf16*)(ws + WS_SB), (bf16*)(ws + WS_VB), nullptr, nullptr, nullptr, nullptr, nullptr); }
        GRID_BAR();
        { unsigned char* ws = load_params().ws; typedef pg8::Cfg<D, D, 16, 1 << 30, -1, 0> CF; pg8::Gemm g{(const bf16*)(ws + WS_VB), (const bf16*)(ws + WS_VB), (const bf16*)(ws + WS_WOUT)};
          pg8::StaticOrder S; S.init(SEQ, D, C.G, C.bid);
          const float* modl = (const float*)(ws + WS_MOD) + (size_t)l * 2 * NMOD; const float* gvl = (const float*)(ws + WS_GV) + (size_t)(l * 4 + 1) * D;
          float* ss2 = (float*)(ws + WS_SS) + (size_t)(l * 2 + 1) * MR;
          { EpiRes<true> E{load_params().out, modl + 2 * D, gvl, (bf16*)(ws + WS_XR), ss2, nullptr, nullptr, nullptr}; pg8::gemm_phase<CF>(ldsl, g, S, E, wv); }
          if constexpr (!last) ctx_gemm<D, D, 1>(wv, lds, (const bf16*)(ws + WS_VB) + (size_t)SEQ * D, (const bf16*)(ws + WS_WOUT), nullptr, nullptr, nullptr, (float*)(ws + WS_XC), modl + NMOD + 2 * D, gvl + 2 * D, (bf16*)(ws + WS_XR), ss2); }
        GRID_BAR();
        { unsigned char* ws = load_params().ws; typedef pg8::Cfg<D, D, 16, 1 << 30, -1, 0> CF; pg8::Gemm g{(const bf16*)(ws + WS_XR), (const bf16*)(ws + WS_XR), (const bf16*)(ws + WS_WGU)};
          pg8::StaticOrder S; S.init(mr, 2 * FF, C.G, C.bid);
          EpiFfn E{(bf16*)(ws + WS_HID), (const float*)(ws + WS_SS) + (size_t)(l * 2 + 1) * MR, (const float*)(ws + WS_CV) + (size_t)l * 2 * NCV + WIN};
          pg8::gemm_phase<CF>(ldsl, g, S, E, wv);
          if constexpr (!last) { const int nfull = ((mr / 256) * 22) % C.G;
              if (nfull) { if (C.bid >= nfull) mixer_prep(lds, wv, 1, C.bid - nfull, C.G - nfull); }
              else mixer_prep(lds, wv, 1, C.bid, C.G); } }
        GRID_BAR();
        { unsigned char* ws = load_params().ws; typedef pg8::Cfg<FF, FF, 16, 1 << 30, -1, 0> CF; pg8::Gemm g{(const bf16*)(ws + WS_HID), (const bf16*)(ws + WS_HID), (const bf16*)(ws + WS_WD)};
          pg8::StaticOrder S; S.init(SEQ, D, C.G, C.bid);
          const float* modl = (const float*)(ws + WS_MOD) + (size_t)l * 2 * NMOD;
          if constexpr (last) { EpiRes<false> E{load_params().out, modl + 5 * D, nullptr, nullptr, nullptr, nullptr, nullptr, nullptr}; pg8::gemm_phase<CF>(ldsl, g, S, E, wv); }
          else { const float* gvn = (const float*)(ws + WS_GV) + (size_t)(4 + 0) * D;
              float* ss1 = (float*)(ws + WS_SS) + (size_t)2 * MR;
              EpiRes<true> E{load_params().out, modl + 5 * D, gvn, (bf16*)(ws + WS_XR), ss1, nullptr, nullptr, nullptr};
              pg8::gemm_phase<CF>(ldsl, g, S, E, wv);
              ctx_gemm<FF, FF, 1>(wv, lds, (const bf16*)(ws + WS_HID) + (size_t)SEQ * FF, (const bf16*)(ws + WS_WD), nullptr, nullptr, nullptr, (float*)(ws + WS_XC), modl + NMOD + 5 * D, gvn + 2 * D, (bf16*)(ws + WS_XR), ss1); } }
        GRID_BAR();
}

__global__ void __launch_bounds__(NT, 2) fwd_megakernel(Params Pk) {
    extern __shared__ __attribute__((aligned(16))) unsigned char lds[];
    const int wv = __builtin_amdgcn_readfirstlane((int)threadIdx.x >> 6);
    Ctx C; C.tid = tid_of(wv); C.lane = C.tid & 63; C.wave = wv; C.wv = wv; C.G = gridDim.x; C.bid = blockIdx.x; C.lds = lds; C.ws = Pk.ws;
    PG8_LAS unsigned char* ldsl = (PG8_LAS unsigned char*)lds;
    volatile LAS unsigned* MISC = (volatile LAS unsigned*)(ldsl + MISC_OFF);
    for (int u = C.tid; u < (LDS_BYTES - 131072) / 4; u += NT) ((LAS unsigned*)(ldsl + 131072))[u] = 0u;
    __syncthreads();
    XcdBarrier bar = xcd_barrier_post((unsigned*)(Pk.ws + WS_CTL), MISC + 8, wv);

    phase_setup(C);
    GRID_BAR();
    rows_first(C);
    mixer_prep(lds, wv, 0, C.bid, C.G);
    build_s5_mats(C, 0, C.bid, C.G);
    build_s5_mats(C, 1, C.bid, C.G);
    GRID_BAR();

    layer_body<0>(C, lds, ldsl, wv, bar);
    layer_body<1>(C, lds, ldsl, wv, bar);
    rows_final(C);
}

extern "C" void kernel_launch(void* const* d_in, const int* in_sizes, int n_in, void* d_out, int out_size, void* d_ws, size_t ws_size, hipStream_t stream) {
    static int grid = 0;
    if (grid == 0) {
        if (n_in != 29 || out_size != SEQ * D || ws_size < WS_END) { fprintf(stderr, "kernel_launch: unexpected shapes (n_in %d out %d ws %zu)\n", n_in, out_size, ws_size); grid = -1; return; }
        int dev = 0, cus = 0, per_cu = 0;
        if (hipGetDevice(&dev) != hipSuccess || hipDeviceGetAttribute(&cus, hipDeviceAttributeMultiprocessorCount, dev) != hipSuccess) { grid = -1; return; }
        if (hipFuncSetAttribute((const void*)fwd_megakernel, hipFuncAttributeMaxDynamicSharedMemorySize, LDS_BYTES) != hipSuccess) { fprintf(stderr, "kernel_launch: hipFuncSetAttribute failed\n"); grid = -1; return; }
        if (hipOccupancyMaxActiveBlocksPerMultiprocessor(&per_cu, (const void*)fwd_megakernel, NT, LDS_BYTES) != hipSuccess || per_cu < 1) { fprintf(stderr, "kernel_launch: occupancy query says %d\n", per_cu); per_cu = 1; }
        (void)hipGetLastError();
        grid = cus;
    }
    if (grid < 0) return;
    (void)hipMemsetAsync((char*)d_ws + WS_CTL, 0, 64 * 1024, stream);
    Params p{};
    const float** pp = (const float**)&p;
    for (int i = 0; i < 29; ++i) pp[i] = (const float*)d_in[i];
    p.out = (float*)d_out; p.ws = (unsigned char*)d_ws;
    hipLaunchKernelGGL(fwd_megakernel, dim3(grid), dim3(NT), LDS_BYTES, stream, p);
}
```
